# Optimizing an MI355X kernel written in HIP

```python
import jax, jax.numpy as jnp
from jax import lax
import numpy as np

D_MODEL = 1024
BATCH = 8
SEQ = 2048
DEPTH = 4

GRID_W = 64
CTX_LEN = 256
BLOCK = 128
WINDOW = 128
ROPE_THETA = 10000.0
EPS = 1e-6
NEG = -1e30

A_HEADS = 8
A_KV = 2
A_HD = 128
B_HEADS = 8
B_KV = 2
B_HD = 128
C_HEADS = 4
C_DK = 256
C_DV = 512
D_FF = 4 * D_MODEL
N_MOD = 6

A_Q = A_HEADS * A_HD
A_KVW = A_KV * A_HD
B_Q = B_HEADS * B_HD
B_KVW = B_KV * B_HD
C_QK = C_HEADS * C_DK
C_V = C_HEADS * C_DV
IN_SIZES = (A_Q, A_KVW, A_KVW, B_Q, B_KVW, B_KVW, C_QK, C_QK, C_V, C_V, D_MODEL, D_MODEL, D_MODEL)
IN_WIDTH = sum(IN_SIZES)

kernel_name = "hybrid_parallel_gqa_window_retention_dit"


def rmsnorm(x, g):
    xf = x.astype(jnp.float32)
    y = xf * lax.rsqrt(jnp.mean(xf * xf, axis=-1, keepdims=True) + EPS)
    return (y * g).astype(x.dtype)


def split_cols(u):
    offs = np.cumsum(IN_SIZES)[:-1].tolist()
    return jnp.split(u, offs, axis=-1)


def heads(x, n, d):
    return x.reshape(x.shape[:-1] + (n, d))


def group(q, n_kv):
    return q.reshape(q.shape[:2] + (n_kv, q.shape[2] // n_kv, q.shape[3]))


def axial_rope(L, dim):
    rows = L // GRID_W
    row = jnp.repeat(jnp.arange(rows), GRID_W).astype(jnp.float32)
    col = jnp.tile(jnp.arange(GRID_W), rows).astype(jnp.float32)
    n = dim // 4
    inv = ROPE_THETA ** (-jnp.arange(n, dtype=jnp.float32) / n)
    ang = jnp.concatenate([row[:, None] * inv, col[:, None] * inv], axis=-1)
    return jnp.cos(ang)[:, None, :], jnp.sin(ang)[:, None, :]


def rope(x, cs):
    cos, sin = cs
    half = x.shape[-1] // 2
    x1, x2 = x[..., :half], x[..., half:]
    out = jnp.concatenate([x1 * cos - x2 * sin, x1 * sin + x2 * cos], axis=-1)
    return out.astype(x.dtype)


def attend(q, k, v, sink=None, mask=None):
    s = jnp.einsum('bqkgd,bskd->bkgqs', q, k).astype(jnp.float32) * (q.shape[-1] ** -0.5)
    if mask is not None:
        s = jnp.where(mask, s, NEG)
    if sink is not None:
        col = jnp.broadcast_to(sink.astype(jnp.float32)[None, :, :, None, None], s.shape[:-1] + (1,))
        p = jax.nn.softmax(jnp.concatenate([s, col], axis=-1), axis=-1)[..., :-1]
    else:
        p = jax.nn.softmax(s, axis=-1)
    return jnp.einsum('bkgqs,bskd->bqkgd', p.astype(v.dtype), v)


def flat(o):
    return o.reshape(o.shape[:2] + (-1,))


def merge_blocks(o):
    o = jnp.moveaxis(o, 0, 1)
    return o.reshape((o.shape[0], o.shape[1] * o.shape[2], -1))


def mixer_a(q, k, v, qc, kc, vc, qn_g, kn_g, cs, need_ctx):
    L = q.shape[1]
    q = group(rope(rmsnorm(heads(q, A_HEADS, A_HD), qn_g), cs), A_KV)
    k = rope(rmsnorm(heads(k, A_KV, A_HD), kn_g), cs)
    v = heads(v, A_KV, A_HD)
    qc = group(rmsnorm(heads(qc, A_HEADS, A_HD), qn_g), A_KV)
    kc = rmsnorm(heads(kc, A_KV, A_HD), kn_g)
    vc = heads(vc, A_KV, A_HD)
    k_all = jnp.concatenate([k, kc], axis=1)
    v_all = jnp.concatenate([v, vc], axis=1)

    def block(i):
        qi = lax.dynamic_slice_in_dim(q, i * BLOCK, BLOCK, axis=1)
        return attend(qi, k_all, v_all)

    y = merge_blocks(lax.map(block, jnp.arange(L // BLOCK)))
    yc = flat(attend(qc, kc, vc)) if need_ctx else None
    return y, yc


def mixer_b(q, k, v, qc, kc, vc, sink, cs, need_ctx):
    L = q.shape[1]
    q = group(rope(heads(q, B_HEADS, B_HD), cs), B_KV)
    k = rope(heads(k, B_KV, B_HD), cs)
    v = heads(v, B_KV, B_HD)
    qc = group(heads(qc, B_HEADS, B_HD), B_KV)
    kc = heads(kc, B_KV, B_HD)
    vc = heads(vc, B_KV, B_HD)
    snk = sink.reshape(B_KV, B_HEADS // B_KV)
    pad = [(0, 0), (BLOCK, BLOCK), (0, 0), (0, 0)]
    kp = jnp.pad(k, pad)
    vp = jnp.pad(v, pad)
    a = jnp.arange(BLOCK)
    j = jnp.arange(3 * BLOCK)
    band = jnp.abs(a[:, None] + BLOCK - j[None, :]) <= WINDOW
    ctx_ok = jnp.ones((BLOCK, kc.shape[1]), dtype=bool)

    def block(i):
        qi = lax.dynamic_slice_in_dim(q, i * BLOCK, BLOCK, axis=1)
        kw = jnp.concatenate([lax.dynamic_slice_in_dim(kp, i * BLOCK, 3 * BLOCK, axis=1), kc], axis=1)
        vw = jnp.concatenate([lax.dynamic_slice_in_dim(vp, i * BLOCK, 3 * BLOCK, axis=1), vc], axis=1)
        pos = i * BLOCK + j - BLOCK
        valid = band & ((pos >= 0) & (pos < L))[None, :]
        m = jnp.concatenate([valid, ctx_ok], axis=1)
        return attend(qi, kw, vw, snk, m)

    y = merge_blocks(lax.map(block, jnp.arange(L // BLOCK)))
    yc = flat(attend(qc, kc, vc, snk)) if need_ctx else None
    return y, yc


def retention(q, k, v, log_gamma, state):
    bsz, L, H, _ = q.shape
    dv = v.shape[-1]
    n = L // BLOCK
    q, k, v = [t.astype(jnp.float32).reshape(bsz, n, BLOCK, H, -1).swapaxes(0, 1) for t in (q, k, v)]
    idx = jnp.arange(BLOCK, dtype=jnp.float32)
    diff = idx[:, None] - idx[None, :]
    decay_in = jnp.where(diff >= 0, jnp.exp(jnp.maximum(diff, 0.0)[None] * log_gamma[:, None, None]), 0.0)
    q_dec = jnp.exp((idx[:, None] + 1.0) * log_gamma[None, :])
    k_dec = jnp.exp((BLOCK - 1.0 - idx)[:, None] * log_gamma[None, :])
    c_dec = jnp.exp(BLOCK * log_gamma)

    def step(S, xs):
        qb, kb, vb = xs
        att = jnp.einsum('bqhd,bshd->bhqs', qb, kb) * decay_in
        o = jnp.einsum('bhqs,bshe->bqhe', att, vb) + jnp.einsum('bqhd,bhde->bqhe', qb * q_dec[:, :, None], S)
        S = S * c_dec[:, None, None] + jnp.einsum('bshd,bshe->bhde', kb * k_dec[:, :, None], vb)
        return S, o

    S, o = lax.scan(step, state, (q, k, v))
    return o.swapaxes(0, 1).reshape(bsz, L, H, dv), S


def mixer_c(q, k, v, g, qc, kc, vc, gc, logit, norm_g, cs, need_ctx):
    scale = C_DK ** -0.5
    q = rope(heads(q, C_HEADS, C_DK), cs)
    k = rope(heads(k, C_HEADS, C_DK), cs) * scale
    v = heads(v, C_HEADS, C_DV)
    qc = heads(qc, C_HEADS, C_DK)
    kc = heads(kc, C_HEADS, C_DK) * scale
    vc = heads(vc, C_HEADS, C_DV)
    lg = jax.nn.log_sigmoid(logit.astype(jnp.float32))
    zero = jnp.zeros((q.shape[0], C_HEADS, C_DK, C_DV), jnp.float32)
    fl = lambda t: jnp.flip(t, axis=1)
    oc_f, s_f = retention(qc, kc, vc, lg[0], zero)
    oc_b, s_b = retention(fl(qc), fl(kc), fl(vc), lg[1], zero)
    o_f, _ = retention(q, k, v, lg[0], s_f)
    o_b, _ = retention(fl(q), fl(k), fl(v), lg[1], s_b)
    gn = norm_g.reshape(C_HEADS, C_DV)

    def out(o, gate):
        o = rmsnorm(o.astype(gate.dtype), gn)
        return o.reshape(o.shape[:2] + (C_V,)) * jax.nn.silu(gate)

    y = out(o_f + fl(o_b), g)
    yc = out(oc_f + fl(oc_b), gc) if need_ctx else None
    return y, yc


def merge(ya, yb, yc, gates, w_pa, w_pb, w_pc, w_o):
    ga, gb, gc = gates
    y = jax.nn.sigmoid(ga) * (ya @ w_pa) + jax.nn.sigmoid(gb) * (yb @ w_pb) + jax.nn.sigmoid(gc) * (yc @ w_pc)
    return y @ w_o


def mlp(h, w1, w2):
    return jnp.square(jax.nn.relu(h @ w1)) @ w2


def setup_inputs(seed: int = 0) -> dict:
    key = jax.random.key(seed)
    ks = jax.random.split(key, 24)
    f32 = jnp.float32
    nrm = lambda k, shape, fan: jax.random.normal(k, shape, f32) * (fan ** -0.5)
    gain = lambda k, shape: 1.0 + 0.05 * jax.random.normal(k, shape, f32)
    gamma0 = 1.0 - 2.0 ** (-5.0 - jnp.arange(C_HEADS, dtype=f32))
    base_logit = jnp.log(gamma0) - jnp.log1p(-gamma0)
    return {
        "x": jax.random.normal(ks[0], (BATCH, SEQ, D_MODEL), f32),
        "c": jax.random.normal(ks[1], (BATCH, D_MODEL), f32),
        "ctx": jax.random.normal(ks[2], (BATCH, CTX_LEN, D_MODEL), f32),
        "c_ctx": jax.random.normal(ks[3], (D_MODEL,), f32),
        "w_ada": 0.5 * nrm(ks[4], (DEPTH, D_MODEL, N_MOD * D_MODEL), D_MODEL),
        "b_ada": 0.02 * jax.random.normal(ks[5], (DEPTH, N_MOD * D_MODEL), f32),
        "norm1_g": gain(ks[6], (DEPTH, D_MODEL)),
        "norm2_g": gain(ks[7], (DEPTH, D_MODEL)),
        "w_in": nrm(ks[8], (DEPTH, D_MODEL, IN_WIDTH), D_MODEL),
        "qn_g": gain(ks[9], (DEPTH, A_HD)),
        "kn_g": gain(ks[10], (DEPTH, A_HD)),
        "sink": jax.random.normal(ks[11], (DEPTH, B_HEADS), f32),
        "ret_logit": base_logit + 0.1 * jax.random.normal(ks[12], (DEPTH, 2, C_HEADS), f32),
        "ret_norm_g": gain(ks[13], (DEPTH, C_V)),
        "w_pa": nrm(ks[14], (DEPTH, A_Q, D_MODEL), A_Q),
        "w_pb": nrm(ks[15], (DEPTH, B_Q, D_MODEL), B_Q),
        "w_pc": nrm(ks[16], (DEPTH, C_V, D_MODEL), C_V),
        "w_o": nrm(ks[17], (DEPTH, D_MODEL, D_MODEL), D_MODEL),
        "w_ff1": nrm(ks[18], (DEPTH, D_MODEL, D_FF), D_MODEL),
        "w_ff2": nrm(ks[19], (DEPTH, D_FF, D_MODEL), D_FF),
        "final_g": gain(ks[20], (D_MODEL,)),
    }


def reference(x, c, ctx, c_ctx, w_ada, b_ada, norm1_g, norm2_g, w_in, qn_g, kn_g, sink,
              ret_logit, ret_norm_g, w_pa, w_pb, w_pc, w_o, w_ff1, w_ff2, final_g):
    L = x.shape[1]
    cs_h = axial_rope(L, A_HD)
    cs_r = axial_rope(L, C_DK)
    s_lat = jax.nn.silu(c)
    s_ctx = jax.nn.silu(c_ctx)[None]
    xc = ctx
    for l in range(DEPTH):
        need_ctx = l < DEPTH - 1
        mod = (s_lat @ w_ada[l] + b_ada[l])[:, None, :]
        modc = (s_ctx @ w_ada[l] + b_ada[l])[:, None, :]
        sh1, sc1, g1, sh2, sc2, g2 = jnp.split(mod, N_MOD, axis=-1)
        sh1c, sc1c, g1c, sh2c, sc2c, g2c = jnp.split(modc, N_MOD, axis=-1)

        h = rmsnorm(x, norm1_g[l]) * (1.0 + sc1) + sh1
        hc = rmsnorm(xc, norm1_g[l]) * (1.0 + sc1c) + sh1c
        u = split_cols(h @ w_in[l])
        uc = split_cols(hc @ w_in[l])

        ya, yac = mixer_a(u[0], u[1], u[2], uc[0], uc[1], uc[2], qn_g[l], kn_g[l], cs_h, need_ctx)
        yb, ybc = mixer_b(u[3], u[4], u[5], uc[3], uc[4], uc[5], sink[l], cs_h, need_ctx)
        yr, yrc = mixer_c(u[6], u[7], u[8], u[9], uc[6], uc[7], uc[8], uc[9],
                          ret_logit[l], ret_norm_g[l], cs_r, need_ctx)

        x = x + g1 * merge(ya, yb, yr, u[10:13], w_pa[l], w_pb[l], w_pc[l], w_o[l])
        x = x + g2 * mlp(rmsnorm(x, norm2_g[l]) * (1.0 + sc2) + sh2, w_ff1[l], w_ff2[l])
        if need_ctx:
            xc = xc + g1c * merge(yac, ybc, yrc, uc[10:13], w_pa[l], w_pb[l], w_pc[l], w_o[l])
            xc = xc + g2c * mlp(rmsnorm(xc, norm2_g[l]) * (1.0 + sc2c) + sh2c, w_ff1[l], w_ff2[l])
    return rmsnorm(x, final_g)
```

```cpp
#include <hip/hip_runtime.h>
#include <hip/hip_cooperative_groups.h>
#include <cstdio>
#include <cstdint>
namespace cg = cooperative_groups;

#define DEVI __device__ __forceinline__
#define LAS __attribute__((address_space(3)))
typedef unsigned short bf16_t;
typedef short bf16x8 __attribute__((ext_vector_type(8)));
typedef short s16x4 __attribute__((ext_vector_type(4)));
typedef float f32x4 __attribute__((ext_vector_type(4)));
typedef float f32x16 __attribute__((ext_vector_type(16)));
typedef unsigned u32x4 __attribute__((ext_vector_type(4)));
typedef unsigned u32x2 __attribute__((ext_vector_type(2)));

constexpr int DM = 1024, NB = 8, SEQ = 2048, DEPTH = 4, CTX = 256;
constexpr int M_LAT = NB * SEQ, M_CTX = NB * CTX, M_ALL = M_LAT + M_CTX;
constexpr int NIN = 12288, DFF = 4096, NMOD = 6 * DM;
constexpr int LDU = NIN;
constexpr int AQ = 0, AK = 1024, AV = 1280, BQ = 1536, BKO = 2560, BV = 2816, CQ = 3072, CK = 4096, CV = 5120, CG = 7168, GA = 9216, GB = 10240, GC = 11264;
constexpr int YOFF = CQ;
constexpr int TAU = SEQ + CTX;
constexpr float EPS = 1e-6f;
constexpr size_t WS_U = 0;
constexpr size_t WS_X = WS_U + (size_t)M_ALL * NIN * 2;
constexpr size_t WS_AP = WS_X + (size_t)M_ALL * DM * 4;
constexpr size_t WS_KT = WS_AP + (size_t)M_ALL * DM * 2;
constexpr size_t WS_VT = WS_KT + (size_t)2 * NB * 4 * 256 * TAU * 2;
constexpr size_t WS_W = WS_VT + (size_t)NB * 4 * 512 * TAU * 2;
constexpr size_t W_IN = 0, W_PA = W_IN + (size_t)NIN * DM * 2, W_PB = W_PA + (size_t)DM * DM * 2, W_PC = W_PB + (size_t)DM * DM * 2,
                 W_O = W_PC + (size_t)DM * 2048 * 2, W_F1 = W_O + (size_t)DM * DM * 2, W_F2 = W_F1 + (size_t)DFF * DM * 2, W_END = W_F2 + (size_t)DM * DFF * 2;
constexpr size_t WS_MOD = WS_W + W_END;
constexpr size_t WS_B1 = WS_MOD + (size_t)DEPTH * 9 * NMOD * 4;
constexpr size_t WS_B2 = WS_B1 + (size_t)DEPTH * 9 * NIN * 4;
constexpr size_t WS_ST = WS_B2 + (size_t)DEPTH * 9 * DFF * 4;
constexpr size_t WS_CSH = WS_ST + (size_t)M_ALL * 16 * 4;
constexpr size_t WS_CSR = WS_CSH + (size_t)SEQ * 64 * 8;
constexpr size_t WS_CTR = WS_CSR + (size_t)SEQ * 128 * 8;
constexpr size_t WS_END = WS_CTR + 4096;
static_assert(WS_END <= 805306368ull, "workspace");

DEVI unsigned cvt_pk_bf16(float lo, float hi) { unsigned r; asm volatile("v_cvt_pk_bf16_f32 %0, %1, %2" : "=v"(r) : "v"(lo), "v"(hi)); return r; }
DEVI float bf_lo(unsigned w) { return __uint_as_float(w << 16); }
DEVI float bf_hi(unsigned w) { return __uint_as_float(w & 0xffff0000u); }
DEVI bf16_t f2bf(float f) { return (bf16_t)(cvt_pk_bf16(f, 0.f) & 0xffffu); }
DEVI float bf2f(bf16_t b) { return __uint_as_float((unsigned)b << 16); }
DEVI float wave_sum(float v) {
#pragma unroll
    for (int o = 1; o < 64; o <<= 1) v += __shfl_xor(v, o);
    return v;
}
DEVI float sigmoidf_(float x) { return 1.f / (1.f + __expf(-x)); }
DEVI float log2_sigmoid(float x) { return -log1pf(__expf(-x)) * 1.4426950408889634f; }
DEVI float fexp2(float x) { return __builtin_amdgcn_exp2f(x); }
DEVI int fresh_tid() { int t = threadIdx.x; asm volatile("" : "+v"(t)); return t; }
DEVI int crow(int r, int hi) { return (r & 3) + 8 * (r >> 2) + 4 * hi; }
#define MFMA32(a, b, c) __builtin_amdgcn_mfma_f32_32x32x16_bf16((a), (b), (c), 0, 0, 0)

namespace pg8 {
constexpr int BM = 256, BK = 64, HALF = 128, HTB = HALF * BK * 2, STAGE_BYTES = 8 * HTB, NXCD = 8, WGM = 8;
__host__ __device__ __forceinline__ int lds_byte(int r, int c) { const int st = (r >> 4) * 2 + (c >> 5), rr = r & 15, cc = c & 31, ob = rr * 64 + cc * 2; return st * 1024 + (ob ^ (((ob >> 9) & 1) << 5)); }
__host__ __device__ __forceinline__ void stage_rc(int b, int& R, int& C) { const int st = b / 1024, sb = b % 1024, swz = sb ^ (((sb >> 9) & 1) << 5); R = (st >> 1) * 16 + swz / 64; C = (st & 1) * 32 + (swz % 64) / 2; }
__host__ __device__ __forceinline__ int perm32(int rho) { const int n = rho >> 4, i = rho & 15; return 8 * (i >> 2) + 4 * n + (i & 3); }
struct Unit { int pm, pn; };
struct Gemm { const bf16_t* A; int lda; const bf16_t* Bt; int K; };
struct StaticOrder {
    int nM, nN, nwg, G, c;
    __device__ void init(int M, int N, int G_, int c_) { nM = M / BM; nN = N / BM; nwg = nM * nN; G = G_; c = c_; }
    __device__ bool next(int i, Unit& u) const {
        const long L = (long)i * G + c; if (L >= nwg) return false;
        int wgid = (int)L; { const int q = nwg / NXCD, r = nwg % NXCD, xcd = wgid % NXCD, off = wgid / NXCD; wgid = (xcd < r ? xcd * (q + 1) : r * (q + 1) + (xcd - r) * q) + off; }
        const int nig = WGM * nN, gid = wgid / nig, fm = gid * WGM, gsz = (nM - fm) < WGM ? (nM - fm) : WGM;
        u.pm = fm + ((wgid % nig) % gsz); u.pn = (wgid % nig) / gsz; return true;
    }
};
template <class Epi>
__device__ __forceinline__ void gemm_phase(LAS unsigned char* lds, const Gemm g, const StaticOrder& S, const Epi& E) {
    const int tid = fresh_tid();
    const int wid = __builtin_amdgcn_readfirstlane(tid >> 6), lane = tid & 63, wr = wid >> 2, wc = wid & 3, fr = lane & 15, fq = lane >> 4;
    const int K = g.K, nt = K / BK, lda = g.lda;
    unsigned voffA[2], voffB[2];
#pragma unroll
    for (int i = 0; i < 2; ++i) { int R, C; stage_rc(tid * 16 + i * 8192, R, C); const int Rb = (R & ~31) + perm32(R & 31);
        voffA[i] = (unsigned)(R * lda + C) * 2u; voffB[i] = (unsigned)(Rb * K + C) * 2u; }
    const size_t kstep = (size_t)(BK * 2);
    const size_t hstepA = (size_t)HALF * lda * 2, hstepB = (size_t)HALF * K * 2;
    const size_t tstepA = 2 * hstepA, tstepB = 2 * hstepB;
    const unsigned ldsw = (unsigned)wid * 1024u;
    const int aoff = lds_byte(wr * 64 + fr, fq * 8), boff = lds_byte(wc * 32 + fr, fq * 8);
#define PG8_SA(b, h) (((b) * 2 + (h)) * HTB)
#define PG8_SB(b, h) ((4 + (b) * 2 + (h)) * HTB)
#define PG8_STAGE(bufoff, gbase, voff) do { _Pragma("unroll") for (int _i = 0; _i < 2; ++_i) \
        __builtin_amdgcn_global_load_lds((const unsigned*)((const char*)(gbase) + (voff)[_i]), (LAS unsigned*)(lds + (bufoff) + ldsw + _i * 8192), 16, 0, 0); } while (0)
#define PG8_LDA(dst, b, h) do { _Pragma("unroll") for (int m = 0; m < 4; ++m) _Pragma("unroll") for (int k = 0; k < 2; ++k) dst[m][k] = *(const LAS bf16x8*)(lds + PG8_SA(b, h) + aoff + m * 2048 + k * 1024); } while (0)
#define PG8_LDB(dst, b, h) do { _Pragma("unroll") for (int n = 0; n < 2; ++n) _Pragma("unroll") for (int k = 0; k < 2; ++k) dst[n][k] = *(const LAS bf16x8*)(lds + PG8_SB(b, h) + boff + n * 2048 + k * 1024); } while (0)
#define PG8_MMA(ai, bj, At, Bt) do { __builtin_amdgcn_s_setprio(1); _Pragma("unroll") for (int m = 0; m < 4; ++m) _Pragma("unroll") for (int n = 0; n < 2; ++n) _Pragma("unroll") for (int k = 0; k < 2; ++k) \
        acc[ai][bj][m][n] = __builtin_amdgcn_mfma_f32_16x16x32_bf16(Bt[n][k], At[m][k], acc[ai][bj][m][n], 0, 0, 0); __builtin_amdgcn_s_setprio(0); } while (0)
#define PG8_WAIT_V(n) asm volatile("s_waitcnt vmcnt(" #n ")" ::: "memory")
#define PG8_WAIT_L(n) asm volatile("s_waitcnt lgkmcnt(" #n ")" ::: "memory")
#define PG8_BAR __builtin_amdgcn_s_barrier()
#define PG8_SCHED __builtin_amdgcn_sched_barrier(0)
    Unit cur, nxt; int ui = 0;
    if (!S.next(0, cur)) return;
    f32x4 acc[2][2][4][2];
#pragma unroll
    for (int a = 0; a < 2; ++a)
#pragma unroll
        for (int b = 0; b < 2; ++b)
#pragma unroll
            for (int m = 0; m < 4; ++m)
#pragma unroll
                for (int n = 0; n < 2; ++n) acc[a][b][m][n] = (f32x4){0.f, 0.f, 0.f, 0.f};
    bf16x8 At[4][2], B0[2][2], B1[2][2];
    const char* cA = (const char*)g.A + (size_t)cur.pm * tstepA; const char* cB = (const char*)g.Bt + (size_t)cur.pn * tstepB;
    PG8_STAGE(PG8_SB(0, 0), cB, voffB); PG8_STAGE(PG8_SB(0, 1), cB + hstepB, voffB); PG8_STAGE(PG8_SA(0, 0), cA, voffA); PG8_STAGE(PG8_SA(0, 1), cA + hstepA, voffA);
    if (wr == 1) PG8_BAR;
    PG8_WAIT_V(2); PG8_BAR;
    PG8_STAGE(PG8_SB(1, 0), cB + kstep, voffB); PG8_STAGE(PG8_SA(1, 0), cA + kstep, voffA); PG8_STAGE(PG8_SB(1, 1), cB + hstepB + kstep, voffB);
    PG8_WAIT_V(6); PG8_BAR;
    for (;;) {
        const bool has_next = S.next(ui + 1, nxt);
        const char* nA = has_next ? (const char*)g.A + (size_t)nxt.pm * tstepA : cA; const char* nB = has_next ? (const char*)g.Bt + (size_t)nxt.pn * tstepB : cB;
        for (int t = 0; t < nt; t += 2) {
            const bool last = (t == nt - 2);
            const char* a1 = cA + (size_t)(t + 1) * kstep;
            const char* a2 = last ? nA : cA + (size_t)(t + 2) * kstep; const char* b2 = last ? nB : cB + (size_t)(t + 2) * kstep;
            const char* a3 = a2 + kstep; const char* b3 = b2 + kstep;
            PG8_LDB(B0, 0, 0); PG8_LDB(B1, 0, 1); PG8_SCHED; PG8_LDA(At, 0, 0); PG8_STAGE(PG8_SA(1, 1), a1 + hstepA, voffA);
            PG8_WAIT_V(8); PG8_WAIT_L(0); PG8_BAR; PG8_MMA(0, 0, At, B0); PG8_MMA(0, 1, At, B1); PG8_BAR; PG8_SCHED;
            PG8_LDA(At, 0, 1); PG8_STAGE(PG8_SB(0, 0), b2, voffB); PG8_STAGE(PG8_SB(0, 1), b2 + hstepB, voffB); PG8_STAGE(PG8_SA(0, 0), a2, voffA);
            PG8_WAIT_V(8); PG8_WAIT_L(0); PG8_BAR; PG8_MMA(1, 0, At, B0); PG8_MMA(1, 1, At, B1); PG8_BAR; PG8_SCHED;
            PG8_LDB(B0, 1, 0); PG8_LDB(B1, 1, 1); PG8_SCHED; PG8_LDA(At, 1, 0); PG8_STAGE(PG8_SA(0, 1), a2 + hstepA, voffA);
            PG8_WAIT_V(8); PG8_WAIT_L(0); PG8_BAR; PG8_MMA(0, 0, At, B0); PG8_MMA(0, 1, At, B1); PG8_BAR; PG8_SCHED;
            PG8_LDA(At, 1, 1); PG8_STAGE(PG8_SB(1, 0), b3, voffB); PG8_STAGE(PG8_SB(1, 1), b3 + hstepB, voffB); PG8_STAGE(PG8_SA(1, 0), a3, voffA);
            PG8_WAIT_V(8); PG8_WAIT_L(0); PG8_BAR; PG8_MMA(1, 0, At, B0); PG8_MMA(1, 1, At, B1); PG8_BAR; PG8_SCHED;
        }
        if (wr == 0) PG8_BAR;
        { int fr_e = fr, fq_e = fq; asm volatile("" : "+v"(fr_e), "+v"(fq_e));
          E(acc, cur, wr, wc, fr_e, fq_e); }
        if (!has_next) break;
#pragma unroll
        for (int a = 0; a < 2; ++a)
#pragma unroll
            for (int b = 0; b < 2; ++b)
#pragma unroll
                for (int m = 0; m < 4; ++m)
#pragma unroll
                    for (int n = 0; n < 2; ++n) acc[a][b][m][n] = (f32x4){0.f, 0.f, 0.f, 0.f};
        cur = nxt; cA = nA; cB = nB; ++ui;
        if (wr == 1) PG8_BAR;
    }
    PG8_WAIT_V(0);
    PG8_BAR;
#undef PG8_SA
#undef PG8_SB
#undef PG8_STAGE
#undef PG8_LDA
#undef PG8_LDB
#undef PG8_MMA
}

DEVI void store8(bf16_t* p, const f32x4 a, const f32x4 b) {
    u32x4 w; w.x = cvt_pk_bf16(a[0], a[1]); w.y = cvt_pk_bf16(a[2], a[3]); w.z = cvt_pk_bf16(b[0], b[1]); w.w = cvt_pk_bf16(b[2], b[3]); *(u32x4*)p = w;
}
DEVI float row_rstd(const float* stats, int row) {
    const f32x4* sp = (const f32x4*)(stats + (size_t)row * 16);
    const f32x4 a = sp[0], b = sp[1], c = sp[2], d = sp[3];
    const float s = ((a[0] + a[1]) + (a[2] + a[3])) + ((b[0] + b[1]) + (b[2] + b[3])) + ((c[0] + c[1]) + (c[2] + c[3])) + ((d[0] + d[1]) + (d[2] + d[3]));
    return rsqrtf(s * (1.f / DM) + EPS);
}

struct EpiIn {
    bf16_t* U; const float* stats; const float* bias; const float* qn_g; const float* kn_g; const float* csh; const float* csr;
    bf16_t* KT; bf16_t* VT; const float* ret_logit; LAS float* xch;
    __device__ __forceinline__ void operator()(f32x4 (&acc)[2][2][4][2], const Unit& u, int wr, int wc, int fr, int fq) const {
        const int pm = u.pm, pn = u.pn;
        const bool lat = pm < 64;
        const int rmod = lat ? (pm >> 3) : 8, bb = lat ? (pm >> 3) : (pm - 64);
        const int pos0 = (pm & 7) * 256, tau0 = lat ? 256 + pos0 : 0;
        const int rowt0 = wr * 64 + fr, w8 = wc * 32 + 8 * fq;
        const bool perm = (pn <= 4) || (pn >= 6 && pn <= 10);
        int cb[2];
#pragma unroll
        for (int bj = 0; bj < 2; ++bj) cb[bj] = perm ? ((w8 >> 6) * 128 + bj * 64 + (w8 & 63)) : (bj * 128 + w8);
        {
            const float* bp = bias + (size_t)rmod * NIN + pn * 256;
            f32x4 bv[2][2];
#pragma unroll
            for (int bj = 0; bj < 2; ++bj)
#pragma unroll
                for (int n = 0; n < 2; ++n) bv[bj][n] = *(const f32x4*)(bp + cb[bj] + 4 * n);
#pragma unroll
            for (int ai = 0; ai < 2; ++ai)
#pragma unroll
                for (int m = 0; m < 4; ++m) {
                    const float rs = row_rstd(stats, pm * 256 + ai * 128 + rowt0 + 16 * m);
#pragma unroll
                    for (int bj = 0; bj < 2; ++bj)
#pragma unroll
                        for (int n = 0; n < 2; ++n) acc[ai][bj][m][n] = acc[ai][bj][m][n] * rs + bv[bj][n];
                    asm volatile("" ::: "memory");
                }
        }
        bf16_t* Ub = U + (size_t)(pm * 256) * LDU + pn * 256;
        const bool norm = perm && (pn <= 4);
        const bool rope128 = perm, rope256 = (pn >= 12 && pn <= 19), rope = (rope128 || rope256) && lat;
        f32x4 g1[2], g2[2];
        if (norm) {
#pragma unroll
            for (int ai = 0; ai < 2; ++ai)
#pragma unroll
                for (int m = 0; m < 4; ++m) {
                    float s = 0.f;
#pragma unroll
                    for (int bj = 0; bj < 2; ++bj)
#pragma unroll
                        for (int n = 0; n < 2; ++n) { const f32x4 x = acc[ai][bj][m][n]; s += (x[0] * x[0] + x[1] * x[1]) + (x[2] * x[2] + x[3] * x[3]); }
                    s += __shfl_xor(s, 16); s += __shfl_xor(s, 32);
                    if (fq == 0) xch[(ai * 128 + rowt0 + 16 * m) * 4 + wc] = s;
                }
            asm volatile("s_waitcnt lgkmcnt(0)" ::: "memory"); __builtin_amdgcn_s_barrier(); asm volatile("" ::: "memory");
            const float* g = (pn < 4) ? qn_g : kn_g;
            const int dd0 = w8 & 63;
#pragma unroll
            for (int n = 0; n < 2; ++n) { g1[n] = *(const f32x4*)(g + dd0 + 4 * n); g2[n] = *(const f32x4*)(g + 64 + dd0 + 4 * n); }
        }
        const float* tab = rope128 ? csh : csr; const int tw = rope128 ? 64 : 128; const int i0 = rope128 ? (w8 & 63) : w8;
        const int kind = (pn >= 16 && pn <= 19) ? 1 : (pn >= 20 && pn <= 27) ? 2 : (pn >= 36) ? 4 : (pn >= 28) ? 3 : 0;
        float lgf = 0.f, lgb = 0.f; bf16_t* t0p = nullptr; bf16_t* t1p = nullptr;
        if (kind == 1) { const int h = pn - 16; lgf = log2_sigmoid(ret_logit[h]); lgb = log2_sigmoid(ret_logit[4 + h]);
            t0p = KT + ((size_t)((0 * NB + bb) * 4 + h) * 256 + w8) * TAU + tau0; t1p = KT + ((size_t)((1 * NB + bb) * 4 + h) * 256 + w8) * TAU + tau0; }
        if (kind == 2) { const int h = (pn - 20) >> 1, e0 = ((pn - 20) & 1) * 256; t0p = VT + ((size_t)(bb * 4 + h) * 512 + e0 + w8) * TAU + tau0; }
#pragma unroll
        for (int ai = 0; ai < 2; ++ai)
#pragma unroll
            for (int m = 0; m < 4; ++m) {
                const int rt = ai * 128 + rowt0 + 16 * m;
                f32x4 v[2][2];
#pragma unroll
                for (int bj = 0; bj < 2; ++bj)
#pragma unroll
                    for (int n = 0; n < 2; ++n) v[bj][n] = acc[ai][bj][m][n];
                if (norm) {
                    const float tot = xch[rt * 4 + wc] + xch[rt * 4 + (wc ^ 1)];
                    const float hr = rsqrtf(tot * (1.f / 128.f) + EPS);
#pragma unroll
                    for (int n = 0; n < 2; ++n) { v[0][n] = v[0][n] * hr * g1[n]; v[1][n] = v[1][n] * hr * g2[n]; }
                }
                if (rope) {
                    const float* tp = tab + ((size_t)(pos0 + rt) * tw + i0) * 2;
#pragma unroll
                    for (int n = 0; n < 2; ++n) {
                        const f32x4 ta = *(const f32x4*)(tp + 8 * n), tb = *(const f32x4*)(tp + 8 * n + 4);
                        const f32x4 x1 = v[0][n], x2 = v[1][n];
                        v[0][n][0] = x1[0] * ta[0] - x2[0] * ta[1]; v[1][n][0] = x1[0] * ta[1] + x2[0] * ta[0];
                        v[0][n][1] = x1[1] * ta[2] - x2[1] * ta[3]; v[1][n][1] = x1[1] * ta[3] + x2[1] * ta[2];
                        v[0][n][2] = x1[2] * tb[0] - x2[2] * tb[1]; v[1][n][2] = x1[2] * tb[1] + x2[2] * tb[0];
                        v[0][n][3] = x1[3] * tb[2] - x2[3] * tb[3]; v[1][n][3] = x1[3] * tb[3] + x2[3] * tb[2];
                    }
                }
                if (kind == 1) {
                    const int sidx = (tau0 + rt) & 127;
                    const float df = fexp2((float)(127 - sidx) * lgf), db = fexp2((float)sidx * lgb);
#pragma unroll
                    for (int bj = 0; bj < 2; ++bj)
#pragma unroll
                        for (int n = 0; n < 2; ++n) {
                            v[bj][n] = v[bj][n] * 0.0625f;
#pragma unroll
                            for (int i = 0; i < 4; ++i) { const size_t o = (size_t)(bj * 128 + 4 * n + i) * TAU + rt; t0p[o] = f2bf(v[bj][n][i] * df); t1p[o] = f2bf(v[bj][n][i] * db); }
                        }
                } else if (kind == 2) {
#pragma unroll
                    for (int bj = 0; bj < 2; ++bj)
#pragma unroll
                        for (int n = 0; n < 2; ++n)
#pragma unroll
                            for (int i = 0; i < 4; ++i) t0p[(size_t)(bj * 128 + 4 * n + i) * TAU + rt] = f2bf(v[bj][n][i]);
                } else if (kind >= 3) {
#pragma unroll
                    for (int bj = 0; bj < 2; ++bj)
#pragma unroll
                        for (int n = 0; n < 2; ++n)
#pragma unroll
                            for (int i = 0; i < 4; ++i) { const float sg = sigmoidf_(v[bj][n][i]); v[bj][n][i] = (kind == 3) ? v[bj][n][i] * sg : sg; }
                }
                if (kind != 2) {
                    store8(Ub + (size_t)rt * LDU + cb[0], v[0][0], v[0][1]);
                    store8(Ub + (size_t)rt * LDU + cb[1], v[1][0], v[1][1]);
                }
                asm volatile("" ::: "memory");
            }
    }
};

struct EpiRes {
    const float* Xin; float* Xout; const float* gate; const float* ng; const float* sc; bf16_t* Ap; float* stats;
    __device__ __forceinline__ void operator()(f32x4 (&acc)[2][2][4][2], const Unit& u, int wr, int wc, int fr, int fq) const {
        const int pm = u.pm, pn = u.pn;
        const int rmod = pm < 64 ? (pm >> 3) : 8;
        const int rowt0 = wr * 64 + fr, w8 = wc * 32 + 8 * fq;
        f32x4 gt[2][2], gm[2][2];
#pragma unroll
        for (int bj = 0; bj < 2; ++bj)
#pragma unroll
            for (int n = 0; n < 2; ++n) {
                const int col = pn * 256 + bj * 128 + w8 + 4 * n;
                gt[bj][n] = *(const f32x4*)(gate + (size_t)rmod * NMOD + col);
                if (ng) { const f32x4 a = *(const f32x4*)(ng + col), b = *(const f32x4*)(sc + (size_t)rmod * NMOD + col); gm[bj][n] = a * (b + 1.0f); }
                else gm[bj][n] = (f32x4){0.f, 0.f, 0.f, 0.f};
            }
#pragma unroll
        for (int ai = 0; ai < 2; ++ai)
#pragma unroll
            for (int m = 0; m < 4; ++m) {
                const size_t row = (size_t)pm * 256 + ai * 128 + rowt0 + 16 * m;
                float ss = 0.f;
#pragma unroll
                for (int bj = 0; bj < 2; ++bj) {
                    const size_t off = row * DM + pn * 256 + bj * 128 + w8;
                    f32x4 x0 = *(const f32x4*)(Xin + off), x1 = *(const f32x4*)(Xin + off + 4);
                    x0 = x0 + gt[bj][0] * acc[ai][bj][m][0]; x1 = x1 + gt[bj][1] * acc[ai][bj][m][1];
                    *(f32x4*)(Xout + off) = x0; *(f32x4*)(Xout + off + 4) = x1;
                    ss += ((x0[0] * x0[0] + x0[1] * x0[1]) + (x0[2] * x0[2] + x0[3] * x0[3])) + ((x1[0] * x1[0] + x1[1] * x1[1]) + (x1[2] * x1[2] + x1[3] * x1[3]));
                    if (ng) store8(Ap + off, x0 * gm[bj][0], x1 * gm[bj][1]);
                }
                ss += __shfl_xor(ss, 16); ss += __shfl_xor(ss, 32);
                if (fq == 0) stats[row * 16 + pn * 4 + wc] = ss;
                asm volatile("" ::: "memory");
            }
    }
};

struct EpiFfn1 {
    bf16_t* H; const float* stats; const float* bias;
    __device__ __forceinline__ void operator()(f32x4 (&acc)[2][2][4][2], const Unit& u, int wr, int wc, int fr, int fq) const {
        const int pm = u.pm, pn = u.pn;
        const int rmod = pm < 64 ? (pm >> 3) : 8;
        const int rowt0 = wr * 64 + fr, w8 = wc * 32 + 8 * fq;
        f32x4 bv[2][2];
#pragma unroll
        for (int bj = 0; bj < 2; ++bj)
#pragma unroll
            for (int n = 0; n < 2; ++n) bv[bj][n] = *(const f32x4*)(bias + (size_t)rmod * DFF + pn * 256 + bj * 128 + w8 + 4 * n);
#pragma unroll
        for (int ai = 0; ai < 2; ++ai)
#pragma unroll
            for (int m = 0; m < 4; ++m) {
                const size_t row = (size_t)pm * 256 + ai * 128 + rowt0 + 16 * m;
                const float rs = row_rstd(stats, (int)row);
#pragma unroll
                for (int bj = 0; bj < 2; ++bj) {
                    f32x4 v0 = acc[ai][bj][m][0] * rs + bv[bj][0], v1 = acc[ai][bj][m][1] * rs + bv[bj][1];
#pragma unroll
                    for (int i = 0; i < 4; ++i) { v0[i] = fmaxf(v0[i], 0.f); v0[i] *= v0[i]; v1[i] = fmaxf(v1[i], 0.f); v1[i] *= v1[i]; }
                    store8(H + row * LDU + pn * 256 + bj * 128 + w8, v0, v1);
                }
            }
    }
};

template <int ACCUM> struct EpiMerge1 {
    bf16_t* U; int goff;
    __device__ __forceinline__ void operator()(f32x4 (&acc)[2][2][4][2], const Unit& u, int wr, int wc, int fr, int fq) const {
        const int pm = u.pm, pn = u.pn;
        const int rowt0 = wr * 64 + fr, w8 = wc * 32 + 8 * fq;
#pragma unroll
        for (int ai = 0; ai < 2; ++ai)
#pragma unroll
            for (int m = 0; m < 4; ++m) {
                const size_t row = (size_t)pm * 256 + ai * 128 + rowt0 + 16 * m;
#pragma unroll
                for (int bj = 0; bj < 2; ++bj) {
                    const int col = pn * 256 + bj * 128 + w8;
                    const u32x4 gw = *(const u32x4*)(U + row * LDU + goff + col);
                    f32x4 v0, v1;
                    v0[0] = bf_lo(gw.x) * acc[ai][bj][m][0][0]; v0[1] = bf_hi(gw.x) * acc[ai][bj][m][0][1]; v0[2] = bf_lo(gw.y) * acc[ai][bj][m][0][2]; v0[3] = bf_hi(gw.y) * acc[ai][bj][m][0][3];
                    v1[0] = bf_lo(gw.z) * acc[ai][bj][m][1][0]; v1[1] = bf_hi(gw.z) * acc[ai][bj][m][1][1]; v1[2] = bf_lo(gw.w) * acc[ai][bj][m][1][2]; v1[3] = bf_hi(gw.w) * acc[ai][bj][m][1][3];
                    bf16_t* yp = U + row * LDU + YOFF + col;
                    if (ACCUM) { const u32x4 pw = *(const u32x4*)yp;
                        v0[0] += bf_lo(pw.x); v0[1] += bf_hi(pw.x); v0[2] += bf_lo(pw.y); v0[3] += bf_hi(pw.y); v1[0] += bf_lo(pw.z); v1[1] += bf_hi(pw.z); v1[2] += bf_lo(pw.w); v1[3] += bf_hi(pw.w); }
                    store8(yp, v0, v1);
                }
            }
    }
};
}

namespace att {
constexpr int D = 128, NW = 8, QBLK = 32, KVBLK = 64;
constexpr float SCALE = 0.088388347648318440f;
constexpr float THR = 8.f;
constexpr size_t SHM_V = KVBLK * D * 2, SHM_K = KVBLK * D * 2, SHM_ATTN = 2 * SHM_V + 2 * SHM_K + NW * 64 * 4;
#define KSWZ(row, colB) ((row) * 256 + ((colB) ^ (((row) & 7) << 4)))
#define SBAR() __builtin_amdgcn_sched_barrier(0)
struct AUnit { const bf16_t* Q; bf16_t* O; const bf16_t* K; const bf16_t* V; int base1, n1, base2, NT; int mask, q0pos, k0pos; float m0, l0; };
DEVI void partialSM(f32x16& p0, f32x16& p1, float& m_reg, float& mn, float& alpha) {
    constexpr float C = SCALE * 1.4426950408889634f;
    float pmax = p0[0];
#pragma unroll
    for (int r = 1; r < 16; ++r) pmax = fmaxf(pmax, p0[r]);
#pragma unroll
    for (int r = 0; r < 16; ++r) pmax = fmaxf(pmax, p1[r]);
    { auto rr = __builtin_amdgcn_permlane32_swap(__float_as_uint(pmax), __float_as_uint(pmax), false, false);
      pmax = fmaxf(__uint_as_float(rr[0]), __uint_as_float(rr[1])); }
    if (__builtin_expect(__all(pmax - m_reg <= THR / SCALE), 1)) { mn = m_reg; alpha = 1.f; }
    else { mn = fmaxf(m_reg, pmax); alpha = __builtin_amdgcn_exp2f((m_reg - mn) * C); m_reg = mn; }
    const float mnC = -mn * C;
#pragma unroll
    for (int r = 0; r < 16; ++r) p0[r] = fmaf(p0[r], C, mnC);
#pragma unroll
    for (int r = 0; r < 16; ++r) p1[r] = fmaf(p1[r], C, mnC);
#pragma unroll
    for (int r = 0; r < 16; ++r) p0[r] = __builtin_amdgcn_exp2f(p0[r]);
}
DEVI void finishSM(f32x16& p0, f32x16& p1, float alpha, float& l_reg, bf16x8& pa0, bf16x8& pa1, bf16x8& pa2, bf16x8& pa3) {
#pragma unroll
    for (int r = 0; r < 16; ++r) p1[r] = __builtin_amdgcn_exp2f(p1[r]);
    float ps = 0;
#pragma unroll
    for (int r = 0; r < 16; ++r) ps += p0[r];
#pragma unroll
    for (int r = 0; r < 16; ++r) ps += p1[r];
    { auto rr = __builtin_amdgcn_permlane32_swap(__float_as_uint(ps), __float_as_uint(ps), false, false);
      ps = __uint_as_float(rr[0]) + __uint_as_float(rr[1]); }
    l_reg = l_reg * alpha + ps;
#define PK4(P, BASE, OUT) do { unsigned a0 = cvt_pk_bf16(P[BASE + 0], P[BASE + 1]), a1 = cvt_pk_bf16(P[BASE + 2], P[BASE + 3]);   \
    unsigned b0 = cvt_pk_bf16(P[BASE + 4], P[BASE + 5]), b1 = cvt_pk_bf16(P[BASE + 6], P[BASE + 7]);                              \
    auto r0 = __builtin_amdgcn_permlane32_swap(a0, b0, false, false); auto r1 = __builtin_amdgcn_permlane32_swap(a1, b1, false, false); \
    u32x4 w = {r0[0], r1[0], r0[1], r1[1]}; OUT = __builtin_bit_cast(bf16x8, w); } while (0)
    PK4(p0, 0, pa0); PK4(p0, 8, pa1); PK4(p1, 0, pa2); PK4(p1, 8, pa3);
#undef PK4
}
DEVI void qkt(f32x16& p0, f32x16& p1, const char* Ks, const bf16x8* qr, int r32, int hi) {
    p0 = f32x16{}; p1 = f32x16{};
#pragma unroll
    for (int d0 = 0; d0 < 8; ++d0) { const int cb = (d0 * 16 + hi * 8) * 2;
        const bf16x8 b0 = *reinterpret_cast<const bf16x8*>(Ks + KSWZ(r32, cb));
        const bf16x8 b1 = *reinterpret_cast<const bf16x8*>(Ks + KSWZ(32 + r32, cb));
        p0 = MFMA32(b0, qr[d0], p0);
        p1 = MFMA32(b1, qr[d0], p1); }
}
DEVI int v_st(int k, int c) { const int kk = (k & ~0xC) | ((k & 4) << 1) | ((k & 8) >> 1); return ((kk >> 3) * 4 + (c >> 5)) * 512 + ((kk & 7) * 32 + (c & 31)) * 2; }
DEVI int v_rd_base(int lane) { return ((lane & 3) << 3) | (((lane >> 2) & 3) << 6) | (((lane >> 4) & 1) << 5) | (((lane >> 5) & 1) << 8); }
constexpr int v_rd_off(int d0, int ks, int half) { return d0 * 512 + ks * 4096 + half * 2048; }
template <int OFF> DEVI s16x4 tr_read(int vb) { s16x4 r; asm volatile("ds_read_b64_tr_b16 %0, %1 offset:%2" : "=&v"(r) : "v"(vb), "i"(OFF) : "memory"); return r; }
template <int D0> DEVI void pv_one(f32x16& od, int vb, bf16x8 pa0, bf16x8 pa1, bf16x8 pa2, bf16x8 pa3) {
    const s16x4 l0 = tr_read<v_rd_off(D0, 0, 0)>(vb), h0 = tr_read<v_rd_off(D0, 0, 1)>(vb), l1 = tr_read<v_rd_off(D0, 1, 0)>(vb), h1 = tr_read<v_rd_off(D0, 1, 1)>(vb);
    const s16x4 l2 = tr_read<v_rd_off(D0, 2, 0)>(vb), h2 = tr_read<v_rd_off(D0, 2, 1)>(vb), l3 = tr_read<v_rd_off(D0, 3, 0)>(vb), h3 = tr_read<v_rd_off(D0, 3, 1)>(vb);
    asm volatile("s_waitcnt lgkmcnt(0)" ::: "memory"); SBAR();
#define PK(L, H) (bf16x8){L[0], L[1], L[2], L[3], H[0], H[1], H[2], H[3]}
    od = MFMA32(pa0, PK(l0, h0), od);
    od = MFMA32(pa1, PK(l1, h1), od);
    od = MFMA32(pa2, PK(l2, h2), od);
    od = MFMA32(pa3, PK(l3, h3), od);
#undef PK
}
DEVI void pv_d0(f32x16* o, int vb, bf16x8 pa0, bf16x8 pa1, bf16x8 pa2, bf16x8 pa3) {
    pv_one<0>(o[0], vb, pa0, pa1, pa2, pa3); pv_one<1>(o[1], vb, pa0, pa1, pa2, pa3); pv_one<2>(o[2], vb, pa0, pa1, pa2, pa3); pv_one<3>(o[3], vb, pa0, pa1, pa2, pa3);
}
DEVI void band_mask(f32x16& p0, f32x16& p1, int qpos, int kt0, int hi) {
#pragma unroll
    for (int r = 0; r < 16; ++r) {
        const int k0 = kt0 + crow(r, hi), d0 = qpos - k0, d1 = d0 - 32;
        if (d0 > 128 || d0 < -128) p0[r] = -INFINITY;
        if (d1 > 128 || d1 < -128) p1[r] = -INFINITY;
    }
}
DEVI void attn_unit(const AUnit& u, char* lds) {
    const int tid = fresh_tid();
    const int wid = tid >> 6, lane = tid & 63, r32 = lane & 31, hi = lane >> 5;
    char* V_lds = lds; char* K_lds = lds + 2 * SHM_V;
    float* ws = (float*)(lds + 2 * SHM_V + 2 * SHM_K) + wid * 64; float* li_l = ws; float* al_l = ws + 32;
    float m_reg = u.m0, l_reg = u.l0; f32x16 o[4] = {}; bf16x8 qr[8];
    const bf16_t* Qw = u.Q + (size_t)(wid * QBLK + r32) * LDU + hi * 8;
#pragma unroll
    for (int d0 = 0; d0 < 8; ++d0) qr[d0] = *reinterpret_cast<const bf16x8*>(Qw + d0 * 16);
    const int sr = tid >> 4, sc = (tid & 15) * 8, vst0 = v_st(sr, sc), vst1 = v_st(32 + sr, sc);
    const int vb0 = (int)(uintptr_t)V_lds + v_rd_base(lane);
    const int qpos = u.q0pos + wid * QBLK + r32;
    struct { bf16x8 vs0, vs1, ks0, ks1; } sr_[2];
#define TROW(t) ((t) < u.n1 ? u.base1 + 64 * (t) : u.base2 + 64 * ((t) - u.n1))
#define SLOAD(i, t) do { const size_t r0_ = (size_t)(TROW(t) + sr) * LDU + sc; \
    sr_[i].vs0 = *reinterpret_cast<const bf16x8*>(u.V + r0_); sr_[i].vs1 = *reinterpret_cast<const bf16x8*>(u.V + r0_ + (size_t)32 * LDU); \
    sr_[i].ks0 = *reinterpret_cast<const bf16x8*>(u.K + r0_); sr_[i].ks1 = *reinterpret_cast<const bf16x8*>(u.K + r0_ + (size_t)32 * LDU); } while (0)
#define SWRITE(b, i) do { *(bf16x8*)(V_lds + (b) * SHM_V + vst0) = sr_[i].vs0;          \
    *(bf16x8*)(V_lds + (b) * SHM_V + vst1) = sr_[i].vs1; const int kc = sc * 2;               \
    *(bf16x8*)(K_lds + (b) * SHM_K + KSWZ(sr, kc)) = sr_[i].ks0;                       \
    *(bf16x8*)(K_lds + (b) * SHM_K + KSWZ(32 + sr, kc)) = sr_[i].ks1; } while (0)
#define SWAIT() asm volatile("s_waitcnt vmcnt(4)" ::: "memory")
#define RESC(a) do { if (__any((a) < 1.f)) { if (hi == 0) al_l[r32] = (a); asm volatile("s_waitcnt lgkmcnt(0)" ::: "memory"); \
    _Pragma("unroll") for (int d = 0; d < 4; ++d) _Pragma("unroll") for (int r = 0; r < 16; ++r) o[d][r] *= al_l[crow(r, hi)]; } } while (0)
#define MASK(P0, P1, t) do { if (u.mask && (t) < u.n1) band_mask(P0, P1, qpos, u.k0pos + 64 * (t), hi); } while (0)
    f32x16 pA0, pA1, pB0, pB1; float mnA, mnB, alA, alB; bf16x8 pa0, pa1, pa2, pa3; const int NT = u.NT;
    constexpr int SE = 0, SO = 1;
    SLOAD(SE, 0); asm volatile("s_waitcnt vmcnt(0)" ::: "memory"); SWRITE(0, SE); __syncthreads();
    qkt(pA0, pA1, K_lds, qr, r32, hi); MASK(pA0, pA1, 0); partialSM(pA0, pA1, m_reg, mnA, alA);
    SLOAD(SO, 1); if (2 < NT) SLOAD(SE, 2);
    if (2 < NT) SWAIT(); else asm volatile("s_waitcnt vmcnt(0)" ::: "memory");
    SWRITE(1, SO); __syncthreads();
    RESC(alA);
    for (int j = 1; j + 1 < NT; j += 2) {
        SBAR(); qkt(pB0, pB1, K_lds + SHM_K, qr, r32, hi); MASK(pB0, pB1, j);
        finishSM(pA0, pA1, alA, l_reg, pa0, pa1, pa2, pa3); SBAR();
        if (j + 2 < NT) SLOAD(SO, j + 2); SBAR();
        pv_d0(o, vb0, pa0, pa1, pa2, pa3); partialSM(pB0, pB1, m_reg, mnB, alB);
        __syncthreads(); if (j + 2 < NT) SWAIT(); else asm volatile("s_waitcnt vmcnt(0)" ::: "memory"); SWRITE(0, SE);
        RESC(alB); __syncthreads();
        SBAR(); qkt(pA0, pA1, K_lds, qr, r32, hi); MASK(pA0, pA1, j + 1);
        finishSM(pB0, pB1, alB, l_reg, pa0, pa1, pa2, pa3); SBAR();
        if (j + 3 < NT) SLOAD(SE, j + 3); SBAR();
        pv_d0(o, vb0 + (int)SHM_V, pa0, pa1, pa2, pa3); partialSM(pA0, pA1, m_reg, mnA, alA);
        __syncthreads(); if (j + 3 < NT) SWAIT(); else asm volatile("s_waitcnt vmcnt(0)" ::: "memory"); SWRITE(1, SO);
        RESC(alA); __syncthreads();
    }
    SBAR(); qkt(pB0, pB1, K_lds + SHM_K, qr, r32, hi); MASK(pB0, pB1, NT - 1);
    finishSM(pA0, pA1, alA, l_reg, pa0, pa1, pa2, pa3); SBAR();
    pv_d0(o, vb0, pa0, pa1, pa2, pa3); partialSM(pB0, pB1, m_reg, mnB, alB);
    __syncthreads(); RESC(alB);
    finishSM(pB0, pB1, alB, l_reg, pa0, pa1, pa2, pa3); SBAR();
    pv_d0(o, vb0 + (int)SHM_V, pa0, pa1, pa2, pa3);
    if (hi == 0) li_l[r32] = l_reg; asm volatile("s_waitcnt lgkmcnt(0)" ::: "memory");
    float rli[16];
#pragma unroll
    for (int r = 0; r < 16; ++r) rli[r] = __builtin_amdgcn_rcpf(li_l[crow(r, hi)]);
    bf16_t* Ow = u.O + (size_t)(wid * QBLK) * LDU;
#pragma unroll
    for (int r = 0; r < 16; ++r) { const int orow = crow(r, hi);
#pragma unroll
        for (int d0 = 0; d0 < 4; ++d0) Ow[(size_t)orow * LDU + d0 * 32 + r32] = f2bf(o[d0][r] * rli[r]); }
    __syncthreads();
#undef TROW
#undef SLOAD
#undef SWRITE
#undef SWAIT
#undef RESC
#undef MASK
}
}

namespace ret {
constexpr int ATT_P = 136, ST_P = 264;
constexpr int LDS_ATT = 0, LDS_ST = 128 * ATT_P * 2, LDS_BYTES = LDS_ST + 64 * ST_P * 2;
DEVI bf16x8 ld8(const bf16_t* p) { return *reinterpret_cast<const bf16x8*>(p); }
DEVI void unit(int b, int h, int es, bf16_t* U, const bf16_t* KT, const bf16_t* VT, float lgf, float lgb, char* lds) {
    const int tid = fresh_tid();
    const int w = __builtin_amdgcn_readfirstlane(tid >> 6), lane = tid & 63;
    bf16_t* att_l = (bf16_t*)(lds + LDS_ATT); bf16_t* st_l = (bf16_t*)(lds + LDS_ST);
    const bf16_t* VTe = VT + ((size_t)(b * 4 + h) * 512 + es * 64) * TAU;
    const int rb = w >> 1;
    for (int dir = 0; dir < 2; ++dir) {
        const float lg = dir ? lgb : lgf;
        const float cdec = fexp2(128.f * lg);
        const bf16_t* KTd = KT + ((size_t)((dir * NB + b) * 4 + h) * 256) * TAU;
        f32x16 accS[2]; accS[0] = f32x16{}; accS[1] = f32x16{};
        for (int step = 0; step < 18; ++step) {
            float lgs = lg; int lane_s = lane; asm volatile("" : "+v"(lgs), "+v"(lane_s));
            const int r32 = lane_s & 31, hi = lane_s >> 5;
            int row0, tau0;
            if (step < 2) { const int j = dir ? 1 - step : step; row0 = M_LAT + b * CTX + 128 * j; tau0 = 128 * j; }
            else { const int c = dir ? 17 - step : step - 2; row0 = b * SEQ + 128 * c; tau0 = 256 + 128 * c; }
            const bf16_t* Qc = U + (size_t)row0 * LDU + CQ + h * 256;
            const bf16_t* Kc = U + (size_t)row0 * LDU + CK + h * 256;
            {
                const int cb0 = 2 * (w & 1);
                f32x16 a0 = f32x16{}, a1 = f32x16{};
                const bool need0 = dir ? (cb0 >= rb) : (cb0 <= rb), need1 = dir ? (cb0 + 1 >= rb) : (cb0 + 1 <= rb);
                const bf16_t* qp = Qc + (size_t)(32 * rb + r32) * LDU + 8 * hi;
                const bf16_t* kp0 = Kc + (size_t)(32 * cb0 + r32) * LDU + 8 * hi; const bf16_t* kp1 = kp0 + (size_t)32 * LDU;
                if (need0 || need1) {
#pragma unroll 4
                    for (int k0 = 0; k0 < 16; ++k0) {
                        const bf16x8 a = ld8(qp + 16 * k0);
                        if (need0) { const bf16x8 bq = ld8(kp0 + 16 * k0); a0 = MFMA32(a, bq, a0); }
                        if (need1) { const bf16x8 bq = ld8(kp1 + 16 * k0); a1 = MFMA32(a, bq, a1); }
                    }
                }
#pragma unroll
                for (int r = 0; r < 16; ++r) {
                    const int qi = 32 * rb + crow(r, hi);
                    const int s0 = 32 * cb0 + r32, s1 = s0 + 32;
                    const int d0 = dir ? s0 - qi : qi - s0, d1 = dir ? s1 - qi : qi - s1;
                    const float v0 = d0 >= 0 ? a0[r] * fexp2((float)d0 * lgs) : 0.f;
                    const float v1 = d1 >= 0 ? a1[r] * fexp2((float)d1 * lgs) : 0.f;
                    att_l[qi * ATT_P + s0] = f2bf(v0); att_l[qi * ATT_P + s1] = f2bf(v1);
                }
            }
            __syncthreads();
            {
                const int cb = w & 1;
                f32x16 acc = f32x16{};
                if (step > 0) {
                    const bf16_t* qp = Qc + (size_t)(32 * rb + r32) * LDU + 8 * hi;
                    const bf16_t* sp = st_l + (32 * cb + r32) * ST_P + 8 * hi;
#pragma unroll 4
                    for (int k0 = 0; k0 < 16; ++k0) { const bf16x8 a = ld8(qp + 16 * k0); const bf16x8 bq = ld8(sp + 16 * k0); acc = MFMA32(a, bq, acc); }
#pragma unroll
                    for (int r = 0; r < 16; ++r) { const int qi = 32 * rb + crow(r, hi); acc[r] *= fexp2((float)(dir ? 128 - qi : qi + 1) * lgs); }
                }
                {
                    const bf16_t* ap = att_l + (32 * rb + r32) * ATT_P + 8 * hi;
                    const bf16_t* vp = VTe + (size_t)(32 * cb + r32) * TAU + tau0 + 8 * hi;
#pragma unroll
                    for (int k0 = 0; k0 < 8; ++k0) { const bf16x8 a = ld8(ap + 16 * k0); const bf16x8 bq = ld8(vp + 16 * k0); acc = MFMA32(a, bq, acc); }
                }
                bf16_t* op = U + (size_t)row0 * LDU + CV + h * 512 + es * 64 + 32 * cb + r32;
#pragma unroll
                for (int r = 0; r < 16; ++r) { const int qi = 32 * rb + crow(r, hi); bf16_t* p = op + (size_t)qi * LDU;
                    float v = acc[r]; if (dir) v += bf2f(*p); *p = f2bf(v); }
            }
            if (step < 17) {
                const bf16_t* kp = KTd + (size_t)(32 * w + r32) * TAU + tau0 + 8 * hi;
                const bf16_t* vp = VTe + (size_t)r32 * TAU + tau0 + 8 * hi;
#pragma unroll
                for (int r = 0; r < 16; ++r) { accS[0][r] *= cdec; accS[1][r] *= cdec; }
#pragma unroll
                for (int k0 = 0; k0 < 8; ++k0) { const bf16x8 a = ld8(kp + 16 * k0); const bf16x8 b0 = ld8(vp + 16 * k0), b1 = ld8(vp + (size_t)32 * TAU + 16 * k0);
                    accS[0] = MFMA32(a, b0, accS[0]); accS[1] = MFMA32(a, b1, accS[1]); }
            }
            __syncthreads();
            if (step < 17) {
#pragma unroll
                for (int cb = 0; cb < 2; ++cb)
#pragma unroll
                    for (int g = 0; g < 4; ++g) {
                        u32x2 pk; pk.x = cvt_pk_bf16(accS[cb][4 * g], accS[cb][4 * g + 1]); pk.y = cvt_pk_bf16(accS[cb][4 * g + 2], accS[cb][4 * g + 3]);
                        *(u32x2*)(st_l + (32 * cb + r32) * ST_P + 32 * w + 8 * g + 4 * hi) = pk;
                    }
            }
        }
        __syncthreads();
    }
}
}

constexpr int NTHR = 512;
constexpr int LDS_XCH = 131072, LDS_MISC = LDS_XCH + 4096, LDS_TOTAL = LDS_MISC + 256;
struct Params { const float* in[21]; float* out; unsigned char* ws; int ph_lo, ph_hi; };
enum { I_X = 0, I_C, I_CTX, I_CCTX, I_WADA, I_BADA, I_N1G, I_N2G, I_WIN, I_QNG, I_KNG, I_SINK, I_RLOGIT, I_RNG, I_WPA, I_WPB, I_WPC, I_WO, I_WF1, I_WF2, I_FG };

DEVI int perm_row(int n) {
    const bool p = (n < 1280) || (n >= 1536 && n < 2816);
    if (!p) return n;
    const int t = n & 255, hd = t >> 7, bj = (t >> 6) & 1, dd = t & 63;
    return (n & ~255) + 128 * bj + 64 * hd + dd;
}
DEVI void transpose_item(const float* W, int K, int N, bf16_t* WT, bool perm, LAS float* scr, int item, int lane) {
    const int nblk = N / 32, kb = item / nblk, nb = item % nblk, k0 = 64 * kb, n0 = 32 * nb;
#pragma unroll 8
    for (int i = 0; i < 32; ++i) { const int kk = 2 * i + (lane >> 5); scr[kk * 33 + (lane & 31)] = W[(size_t)(k0 + kk) * N + n0 + (lane & 31)]; }
    asm volatile("s_waitcnt lgkmcnt(0)" ::: "memory");
    const int c = lane & 7;
#pragma unroll
    for (int j = 0; j < 4; ++j) { const int n = (lane >> 3) + 8 * j; const LAS float* s = scr + (8 * c) * 33 + n;
        u32x4 o; o.x = cvt_pk_bf16(s[0 * 33], s[1 * 33]); o.y = cvt_pk_bf16(s[2 * 33], s[3 * 33]); o.z = cvt_pk_bf16(s[4 * 33], s[5 * 33]); o.w = cvt_pk_bf16(s[6 * 33], s[7 * 33]);
        const int nd = perm ? perm_row(n0 + n) : (n0 + n);
        *(u32x4*)(WT + (size_t)nd * K + k0 + 8 * c) = o; }
    asm volatile("s_waitcnt lgkmcnt(0)" ::: "memory");
}
DEVI void convert_weight(const float* W, int K, int N, bf16_t* WT, bool perm, LAS unsigned char* lds) {
    const int tid = fresh_tid(); const int wave = tid >> 6, lane = tid & 63;
    LAS float* scr = (LAS float*)(lds + wave * 16384);
    const int items = (K / 64) * (N / 32);
    for (int it = blockIdx.x * 8 + wave; it < items; it += gridDim.x * 8) transpose_item(W, K, N, WT, perm, scr, it, lane);
}
DEVI void dot9_item(const float* W, int ldw, int n0, const float* bvec, float* out, int ldo, LAS float* sL, LAS float* red) {
    const int tid = fresh_tid(); const int wave = tid >> 6, lane = tid & 63;
    float a[9];
#pragma unroll
    for (int r = 0; r < 9; ++r) a[r] = 0.f;
    const float* wp = W + (size_t)(wave * 128) * ldw + n0 + lane;
#pragma unroll 8
    for (int k = 0; k < 128; ++k) { const float wv = wp[(size_t)k * ldw];
#pragma unroll
        for (int r = 0; r < 9; ++r) a[r] += sL[r * 1024 + wave * 128 + k] * wv; }
#pragma unroll
    for (int r = 0; r < 9; ++r) red[(wave * 9 + r) * 64 + lane] = a[r];
    __syncthreads();
    for (int o = tid; o < 9 * 64; o += NTHR) { const int r = o >> 6, c = o & 63; float s = 0.f;
#pragma unroll
        for (int w = 0; w < 8; ++w) s += red[(w * 9 + r) * 64 + c];
        out[(size_t)r * ldo + n0 + c] = s + (bvec ? bvec[n0 + c] : 0.f); }
    __syncthreads();
}
DEVI void sincos_f(float ang, float& c, float& s) {
    const float q = rintf(ang * 0.6366197723675814f);
    float r = fmaf(-q, 1.5703125f, ang); r = fmaf(-q, 4.837512969970703125e-4f, r); r = fmaf(-q, 7.549789948768648e-8f, r);
    const float r2 = r * r;
    const float sp = r + r * r2 * (-1.6666667163e-1f + r2 * (8.3333337680e-3f + r2 * (-1.9841270114e-4f + r2 * 2.7557314297e-6f)));
    const float cp = 1.f + r2 * (-0.5f + r2 * (4.1666667908e-2f + r2 * (-1.3888889225e-3f + r2 * (2.4801587642e-5f + r2 * -2.7557314297e-7f))));
    const int qi = ((int)q) & 3;
    c = (qi == 0) ? cp : (qi == 1) ? -sp : (qi == 2) ? -cp : sp;
    s = (qi == 0) ? sp : (qi == 1) ? cp : (qi == 2) ? -sp : -cp;
}

__global__ void __launch_bounds__(NTHR, 2) mega_fwd(Params P) {
    extern __shared__ __attribute__((aligned(16))) unsigned char lds_raw[];
    cg::grid_group grid = cg::this_grid();
    LAS unsigned char* lds = (LAS unsigned char*)lds_raw;
    const int G = gridDim.x, NGW = G * 8;
#define PHASE_IDS() const int tid = fresh_tid(); const int wave = tid >> 6, lane = tid & 63, gw = blockIdx.x * 8 + wave; (void)lane; (void)gw; (void)wave
    unsigned char* ws = P.ws;
    bf16_t* U = (bf16_t*)(ws + WS_U); float* X = (float*)(ws + WS_X); bf16_t* AP = (bf16_t*)(ws + WS_AP);
    bf16_t* KT = (bf16_t*)(ws + WS_KT); bf16_t* VT = (bf16_t*)(ws + WS_VT);
    bf16_t* Wb = (bf16_t*)(ws + WS_W);
    bf16_t* Win_t = (bf16_t*)(ws + WS_W + W_IN); bf16_t* Wpa_t = (bf16_t*)(ws + WS_W + W_PA); bf16_t* Wpb_t = (bf16_t*)(ws + WS_W + W_PB); bf16_t* Wpc_t = (bf16_t*)(ws + WS_W + W_PC);
    bf16_t* Wo_t = (bf16_t*)(ws + WS_W + W_O); bf16_t* Wf1_t = (bf16_t*)(ws + WS_W + W_F1); bf16_t* Wf2_t = (bf16_t*)(ws + WS_W + W_F2);
    float* MOD = (float*)(ws + WS_MOD); float* B1 = (float*)(ws + WS_B1); float* B2 = (float*)(ws + WS_B2); float* ST = (float*)(ws + WS_ST);
    float* CSH = (float*)(ws + WS_CSH); float* CSR = (float*)(ws + WS_CSR); unsigned* CTR = (unsigned*)(ws + WS_CTR);
    (void)Wb;
    int ph = 0;
#define PHASE_ON() (P.ph_lo <= ph && ph < P.ph_hi)
#define PHASE_END() do { if (P.ph_lo <= ph && ph + 1 < P.ph_hi) grid.sync(); ++ph; } while (0)

    if (PHASE_ON()) { PHASE_IDS();
        if (blockIdx.x == 0 && tid < 64) CTR[tid] = 0u;
        {
            LAS float* sL = (LAS float*)lds; LAS float* red = (LAS float*)(lds + 9 * 1024 * 4);
            for (int i = tid; i < 9 * 1024; i += NTHR) { const float v = (i < 8192) ? P.in[I_C][i] : P.in[I_CCTX][i - 8192]; sL[i] = v * sigmoidf_(v); }
            __syncthreads();
            for (int it = blockIdx.x; it < DEPTH * (NMOD / 64); it += G) { const int l = it / (NMOD / 64), n0 = (it % (NMOD / 64)) * 64;
                dot9_item(P.in[I_WADA] + (size_t)l * DM * NMOD, NMOD, n0, P.in[I_BADA] + (size_t)l * NMOD, MOD + (size_t)l * 9 * NMOD, NMOD, sL, red); }
            __syncthreads();
        }
        convert_weight(P.in[I_WIN], DM, NIN, Win_t, true, lds);
        convert_weight(P.in[I_WPA], DM, DM, Wpa_t, false, lds);
        convert_weight(P.in[I_WPB], DM, DM, Wpb_t, false, lds);
        convert_weight(P.in[I_WPC], 2048, DM, Wpc_t, false, lds);
        convert_weight(P.in[I_WO], DM, DM, Wo_t, false, lds);
        convert_weight(P.in[I_WF1], DM, DFF, Wf1_t, false, lds);
        convert_weight(P.in[I_WF2], DFF, DM, Wf2_t, false, lds);
        for (int i = blockIdx.x * NTHR + tid; i < SEQ * 64; i += G * NTHR) { const int pos = i >> 6, dd = i & 63, j = dd & 31, p = dd < 32 ? (pos >> 6) : (pos & 63);
            const float inv = fexp2(-(float)j * (13.287712379549449f / 32.f)); float c, s; sincos_f((float)p * inv, c, s); CSH[2 * i] = c; CSH[2 * i + 1] = s; }
        for (int i = blockIdx.x * NTHR + tid; i < SEQ * 128; i += G * NTHR) { const int pos = i >> 7, dd = i & 127, j = dd & 63, p = dd < 64 ? (pos >> 6) : (pos & 63);
            const float inv = fexp2(-(float)j * (13.287712379549449f / 64.f)); float c, s; sincos_f((float)p * inv, c, s); CSR[2 * i] = c; CSR[2 * i + 1] = s; }
        __syncthreads();
    }
    PHASE_END();

    if (PHASE_ON()) { PHASE_IDS();
        LAS float* sL = (LAS float*)lds; LAS float* red = (LAS float*)(lds + 9 * 1024 * 4);
        constexpr int IT1 = NIN / 64, IT2 = DFF / 64;
        for (int it = blockIdx.x; it < DEPTH * (IT1 + IT2); it += G) {
            const int l = it / (IT1 + IT2), r = it % (IT1 + IT2); const bool first = r < IT1;
            const float* md = MOD + (size_t)l * 9 * NMOD + (first ? 0 : 3 * DM);
            for (int i = tid; i < 9 * 1024; i += NTHR) sL[i] = md[(size_t)(i >> 10) * NMOD + (i & 1023)];
            __syncthreads();
            if (first) dot9_item(P.in[I_WIN] + (size_t)l * DM * NIN, NIN, r * 64, nullptr, B1 + (size_t)l * 9 * NIN, NIN, sL, red);
            else dot9_item(P.in[I_WF1] + (size_t)l * DM * DFF, DFF, (r - IT1) * 64, nullptr, B2 + (size_t)l * 9 * DFF, DFF, sL, red);
        }
        for (int row = gw; row < M_ALL; row += NGW) {
            const bool lat = row < M_LAT; const int rmod = lat ? (row >> 11) : 8;
            const float* src = lat ? P.in[I_X] + (size_t)row * DM : P.in[I_CTX] + (size_t)(row - M_LAT) * DM;
            const float* scp = MOD + (size_t)rmod * NMOD + DM; const float* ng = P.in[I_N1G];
            float ss = 0.f;
#pragma unroll
            for (int j = 0; j < 4; ++j) { const int c = 4 * lane + 256 * j; const f32x4 v = *(const f32x4*)(src + c);
                *(f32x4*)(X + (size_t)row * DM + c) = v; ss += (v[0] * v[0] + v[1] * v[1]) + (v[2] * v[2] + v[3] * v[3]);
                const f32x4 g = *(const f32x4*)(ng + c), s = *(const f32x4*)(scp + c); const f32x4 a = v * (g * (s + 1.0f));
                u32x2 pk; pk.x = cvt_pk_bf16(a[0], a[1]); pk.y = cvt_pk_bf16(a[2], a[3]); *(u32x2*)(AP + (size_t)row * DM + c) = pk; }
            ss = wave_sum(ss);
            if (lane < 16) ST[(size_t)row * 16 + lane] = lane == 0 ? ss : 0.f;
        }
    }
    PHASE_END();

    for (int l = 0; l < DEPTH; ++l) {
        const bool need_ctx = l < DEPTH - 1;
        const float* MODl = MOD + (size_t)l * 9 * NMOD;
        const int M2 = need_ctx ? M_ALL : M_LAT;
        if (PHASE_ON()) { PHASE_IDS();
            if (l > 0) convert_weight(P.in[I_WF2] + (size_t)l * DFF * DM, DFF, DM, Wf2_t, false, lds);
            __syncthreads();
            pg8::Gemm g{AP, DM, Win_t, DM}; pg8::StaticOrder S; S.init(M_ALL, NIN, G, (int)blockIdx.x);
            pg8::EpiIn E{U, ST, B1 + (size_t)l * 9 * NIN, P.in[I_QNG] + l * 128, P.in[I_KNG] + l * 128, CSH, CSR, KT, VT, P.in[I_RLOGIT] + l * 8, (LAS float*)(lds + LDS_XCH)};
            pg8::gemm_phase(lds, g, S, E);
        }
        PHASE_END();
        if (PHASE_ON()) { PHASE_IDS();
            if (l + 1 < DEPTH) { convert_weight(P.in[I_WIN] + (size_t)(l + 1) * DM * NIN, DM, NIN, Win_t, true, lds); __syncthreads(); }
            LAS int* misc = (LAS int*)(lds + LDS_MISC);
            const int n_ret = 256, n_a = 512, n_b = 512, n_c = need_ctx ? 128 : 0, total = n_ret + n_a + n_b + n_c;
            for (;;) {
                if (tid == 0) misc[0] = (int)atomicAdd(&CTR[l * 16], 1u);
                __syncthreads();
                const int ui = misc[0];
                __syncthreads();
                if (ui >= total) break;
                if (ui < n_ret) {
                    const int b = ui >> 5, h = (ui >> 3) & 3, es = ui & 7;
                    const float lgf = log2_sigmoid(P.in[I_RLOGIT][l * 8 + h]), lgb = log2_sigmoid(P.in[I_RLOGIT][l * 8 + 4 + h]);
                    ret::unit(b, h, es, U, KT, VT, lgf, lgb, (char*)lds_raw);
                } else {
                    att::AUnit a; int i = ui - n_ret;
                    if (i < n_a) {
                        const int b = i >> 6, h = (i >> 3) & 7, qb = i & 7, kv = h >> 2; const size_t qrow = (size_t)b * SEQ + qb * 256;
                        a.Q = U + qrow * LDU + AQ + h * 128; a.O = U + qrow * LDU + AQ + h * 128; a.K = U + AK + kv * 128; a.V = U + AV + kv * 128;
                        a.base1 = b * SEQ; a.n1 = 32; a.base2 = M_LAT + b * CTX; a.NT = 36; a.mask = 0; a.q0pos = 0; a.k0pos = 0; a.m0 = -1e30f; a.l0 = 0.f;
                    } else if (i < n_a + n_b) {
                        i -= n_a; const int b = i >> 6, h = (i >> 3) & 7, qb = i & 7, kv = h >> 2; const size_t qrow = (size_t)b * SEQ + qb * 256;
                        const int ks = qb == 0 ? 0 : qb * 256 - 128, ke = qb == 7 ? SEQ : qb * 256 + 384;
                        a.Q = U + qrow * LDU + BQ + h * 128; a.O = U + qrow * LDU + BQ + h * 128; a.K = U + BKO + kv * 128; a.V = U + BV + kv * 128;
                        a.base1 = b * SEQ + ks; a.n1 = (ke - ks) / 64; a.base2 = M_LAT + b * CTX; a.NT = a.n1 + 4; a.mask = 1; a.q0pos = qb * 256; a.k0pos = ks;
                        a.m0 = P.in[I_SINK][l * 8 + h] * (1.f / att::SCALE); a.l0 = 1.f;
                    } else {
                        i -= n_a + n_b; const int isb = i >> 6, b = (i >> 3) & 7, h = i & 7, kv = h >> 2; const size_t qrow = (size_t)M_LAT + b * CTX;
                        const int qo = isb ? BQ : AQ, ko = isb ? BKO : AK, vo = isb ? BV : AV;
                        a.Q = U + qrow * LDU + qo + h * 128; a.O = U + qrow * LDU + qo + h * 128; a.K = U + ko + kv * 128; a.V = U + vo + kv * 128;
                        a.base1 = 0; a.n1 = 0; a.base2 = M_LAT + b * CTX; a.NT = 4; a.mask = 0; a.q0pos = 0; a.k0pos = 0;
                        a.m0 = isb ? P.in[I_SINK][l * 8 + h] * (1.f / att::SCALE) : -1e30f; a.l0 = isb ? 1.f : 0.f;
                    }
                    att::attn_unit(a, (char*)lds_raw);
                }
            }
        }
        PHASE_END();
        if (PHASE_ON()) { PHASE_IDS();
            const float* gn = P.in[I_RNG] + (size_t)l * 2048;
            for (int it = gw; it < M2 * 4; it += NGW) { const int row = it >> 2, h = it & 3;
                const u32x4 ow = *(const u32x4*)(U + (size_t)row * LDU + CV + h * 512 + 8 * lane);
                bf16_t* gp = U + (size_t)row * LDU + CG + h * 512 + 8 * lane; const u32x4 gw4 = *(const u32x4*)gp;
                float o[8] = {bf_lo(ow.x), bf_hi(ow.x), bf_lo(ow.y), bf_hi(ow.y), bf_lo(ow.z), bf_hi(ow.z), bf_lo(ow.w), bf_hi(ow.w)};
                const float gg[8] = {bf_lo(gw4.x), bf_hi(gw4.x), bf_lo(gw4.y), bf_hi(gw4.y), bf_lo(gw4.z), bf_hi(gw4.z), bf_lo(gw4.w), bf_hi(gw4.w)};
                float ss = 0.f;
#pragma unroll
                for (int j = 0; j < 8; ++j) ss += o[j] * o[j];
                ss = wave_sum(ss); const float rs = rsqrtf(ss * (1.f / 512.f) + EPS);
                const f32x4 n0 = *(const f32x4*)(gn + h * 512 + 8 * lane), n1 = *(const f32x4*)(gn + h * 512 + 8 * lane + 4);
                f32x4 y0, y1;
#pragma unroll
                for (int j = 0; j < 4; ++j) { y0[j] = o[j] * rs * n0[j] * gg[j]; y1[j] = o[4 + j] * rs * n1[j] * gg[4 + j]; }
                pg8::store8(gp, y0, y1); }
        }
        PHASE_END();
        if (PHASE_ON()) { PHASE_IDS();
            pg8::StaticOrder S; S.init(M2, DM, G, (int)blockIdx.x);
            { pg8::Gemm g{U + AQ, LDU, Wpa_t, DM}; pg8::EpiMerge1<0> E{U, GA}; pg8::gemm_phase(lds, g, S, E); }
            { pg8::Gemm g{U + BQ, LDU, Wpb_t, DM}; pg8::EpiMerge1<1> E{U, GB}; pg8::gemm_phase(lds, g, S, E); }
            { pg8::Gemm g{U + CG, LDU, Wpc_t, 2048}; pg8::EpiMerge1<1> E{U, GC}; pg8::gemm_phase(lds, g, S, E); }
        }
        PHASE_END();
        if (PHASE_ON()) { PHASE_IDS();
            if (l + 1 < DEPTH) {
                convert_weight(P.in[I_WPA] + (size_t)(l + 1) * DM * DM, DM, DM, Wpa_t, false, lds);
                convert_weight(P.in[I_WPB] + (size_t)(l + 1) * DM * DM, DM, DM, Wpb_t, false, lds);
                convert_weight(P.in[I_WPC] + (size_t)(l + 1) * 2048 * DM, 2048, DM, Wpc_t, false, lds);
                __syncthreads();
            }
            pg8::Gemm g{U + YOFF, LDU, Wo_t, DM}; pg8::StaticOrder S; S.init(M2, DM, G, (int)blockIdx.x);
            pg8::EpiRes E{X, X, MODl + 2 * DM, P.in[I_N2G] + (size_t)l * DM, MODl + 4 * DM, AP, ST};
            pg8::gemm_phase(lds, g, S, E);
        }
        PHASE_END();
        if (PHASE_ON()) { PHASE_IDS();
            if (l + 1 < DEPTH) { convert_weight(P.in[I_WO] + (size_t)(l + 1) * DM * DM, DM, DM, Wo_t, false, lds); __syncthreads(); }
            pg8::Gemm g{AP, DM, Wf1_t, DM}; pg8::StaticOrder S; S.init(M2, DFF, G, (int)blockIdx.x);
            pg8::EpiFfn1 E{U, ST, B2 + (size_t)l * 9 * DFF};
            pg8::gemm_phase(lds, g, S, E);
        }
        PHASE_END();
        if (PHASE_ON()) { PHASE_IDS();
            if (l + 1 < DEPTH) { convert_weight(P.in[I_WF1] + (size_t)(l + 1) * DM * DFF, DM, DFF, Wf1_t, false, lds); __syncthreads(); }
            pg8::Gemm g{U, LDU, Wf2_t, DFF}; pg8::StaticOrder S; S.init(M2, DM, G, (int)blockIdx.x);
            const float* MODn = MOD + (size_t)(l + 1) * 9 * NMOD;
            pg8::EpiRes E{X, need_ctx ? X : P.out, MODl + 5 * DM, need_ctx ? P.in[I_N1G] + (size_t)(l + 1) * DM : nullptr, need_ctx ? MODn + DM : nullptr, AP, ST};
            pg8::gemm_phase(lds, g, S, E);
        }
        PHASE_END();
    }
    if (PHASE_ON()) { PHASE_IDS();
        const float* fg = P.in[I_FG];
        for (int row = gw; row < M_LAT; row += NGW) {
            const float rs = pg8::row_rstd(ST, row);
#pragma unroll
            for (int j = 0; j < 4; ++j) { const int c = 4 * lane + 256 * j; float* p = P.out + (size_t)row * DM + c;
                const f32x4 v = *(const f32x4*)p, g = *(const f32x4*)(fg + c); *(f32x4*)p = v * rs * g; }
        }
    }
}
constexpr int N_PHASES = 2 + 7 * DEPTH + 1;

extern "C" void kernel_launch(void* const* d_in, const int* in_sizes, int n_in, void* d_out, int out_size, void* d_ws, size_t ws_size, hipStream_t stream) {
    static int grid = 0;
    if (grid == 0) {
        if (n_in != 21 || out_size != M_LAT * DM || ws_size < WS_END) { fprintf(stderr, "kernel_launch: unexpected shapes (n_in %d out %d ws %zu need %zu)\n", n_in, out_size, ws_size, (size_t)WS_END); grid = -1; return; }
        int dev = 0, cus = 0, per_cu = 0;
        hipGetDevice(&dev); hipDeviceGetAttribute(&cus, hipDeviceAttributeMultiprocessorCount, dev);
        if (hipFuncSetAttribute((const void*)mega_fwd, hipFuncAttributeMaxDynamicSharedMemorySize, LDS_TOTAL) != hipSuccess) { fprintf(stderr, "kernel_launch: LDS attribute failed\n"); grid = -1; return; }
        hipOccupancyMaxActiveBlocksPerMultiprocessor(&per_cu, (const void*)mega_fwd, NTHR, LDS_TOTAL);
        if (per_cu < 1) { fprintf(stderr, "kernel_launch: occupancy query says %d\n", per_cu); per_cu = 1; }
        (void)hipGetLastError();
        grid = cus;
    }
    if (grid < 0) return;
    Params p{};
    for (int i = 0; i < 21; ++i) p.in[i] = (const float*)d_in[i];
    p.out = (float*)d_out; p.ws = (unsigned char*)d_ws; p.ph_lo = 0; p.ph_hi = N_PHASES;
    void* args[] = {&p};
    hipError_t e = hipLaunchCooperativeKernel((const void*)mega_fwd, dim3(grid), dim3(NTHR), args, LDS_TOTAL, stream);
    if (e != hipSuccess) fprintf(stderr, "cooperative launch failed: %s (grid %d)\n", hipGetErrorString(e), grid);
}
```

```cpp
#include <hip/hip_runtime.h>
#include <hip/hip_cooperative_groups.h>
#include <cstdio>
#include <cstdint>
namespace cg = cooperative_groups;

#define DEVI __device__ __forceinline__
#define LAS __attribute__((address_space(3)))
typedef unsigned short bf16_t;
typedef short bf16x8 __attribute__((ext_vector_type(8)));
typedef short s16x4 __attribute__((ext_vector_type(4)));
typedef float f32x4 __attribute__((ext_vector_type(4)));
typedef float f32x16 __attribute__((ext_vector_type(16)));
typedef unsigned u32x4 __attribute__((ext_vector_type(4)));
typedef unsigned u32x2 __attribute__((ext_vector_type(2)));

constexpr int DM = 1024, NB = 8, SEQ = 2048, DEPTH = 4, CTX = 256;
constexpr int M_LAT = NB * SEQ, M_CTX = NB * CTX, M_ALL = M_LAT + M_CTX;
constexpr int NIN = 12288, DFF = 4096, NMOD = 6 * DM;
constexpr int LDU = NIN;
constexpr int AQ = 0, AK = 1024, AV = 1280, BQ = 1536, BKO = 2560, BV = 2816, CQ = 3072, CK = 4096, CV = 5120, CG = 7168, GA = 9216, GB = 10240, GC = 11264;
constexpr int YOFF = CQ;
constexpr int TAU = SEQ + CTX;
constexpr float EPS = 1e-6f;
constexpr size_t WS_U = 0;
constexpr size_t WS_X = WS_U + (size_t)M_ALL * NIN * 2;
constexpr size_t WS_AP = WS_X + (size_t)M_ALL * DM * 4;
constexpr size_t WS_KT = WS_AP + (size_t)M_ALL * DM * 2;
constexpr size_t WS_VT = WS_KT + (size_t)2 * NB * 4 * 256 * TAU * 2;
constexpr size_t WS_W = WS_VT + (size_t)NB * 4 * 512 * TAU * 2;
constexpr size_t W_IN = 0, W_PA = W_IN + (size_t)NIN * DM * 2, W_PB = W_PA + (size_t)DM * DM * 2, W_PC = W_PB + (size_t)DM * DM * 2,
                 W_O = W_PC + (size_t)DM * 2048 * 2, W_F1 = W_O + (size_t)DM * DM * 2, W_F2 = W_F1 + (size_t)DFF * DM * 2, W_END = W_F2 + (size_t)DM * DFF * 2;
constexpr size_t W_SM = W_END - W_PA;
constexpr size_t WS_MOD = WS_W + W_END + W_SM;
constexpr size_t WS_B1 = WS_MOD + (size_t)DEPTH * 9 * NMOD * 4;
constexpr size_t WS_B2 = WS_B1 + (size_t)DEPTH * 9 * NIN * 4;
constexpr size_t WS_ST = WS_B2 + (size_t)DEPTH * 9 * DFF * 4;
constexpr size_t WS_CSH = WS_ST + (size_t)M_ALL * 16 * 4;
constexpr size_t WS_CSR = WS_CSH + (size_t)SEQ * 64 * 8;
constexpr size_t WS_CTR = WS_CSR + (size_t)SEQ * 128 * 8;
constexpr size_t WS_CNT = WS_CTR + 4096;
constexpr size_t WS_BAR = WS_CNT + 5 * 72 * 256;
constexpr size_t WS_END = WS_BAR + 16384;
static_assert(WS_END <= 805306368ull, "workspace");

DEVI unsigned cvt_pk_bf16(float lo, float hi) { unsigned r; asm volatile("v_cvt_pk_bf16_f32 %0, %1, %2" : "=v"(r) : "v"(lo), "v"(hi)); return r; }
typedef float f32x2_t __attribute__((ext_vector_type(2))); typedef __bf16 bf16x2_t __attribute__((ext_vector_type(2)));
DEVI unsigned cvt_pk_bf16_c(float lo, float hi) { const f32x2_t v = {lo, hi}; const bf16x2_t b = __builtin_convertvector(v, bf16x2_t); return __builtin_bit_cast(unsigned, b); }
DEVI float bf_lo(unsigned w) { return __uint_as_float(w << 16); }
DEVI float bf_hi(unsigned w) { return __uint_as_float(w & 0xffff0000u); }
DEVI bf16_t f2bf(float f) { return (bf16_t)(cvt_pk_bf16(f, 0.f) & 0xffffu); }
DEVI float bf2f(bf16_t b) { return __uint_as_float((unsigned)b << 16); }
DEVI float wave_sum(float v) {
#pragma unroll
    for (int o = 1; o < 64; o <<= 1) v += __shfl_xor(v, o);
    return v;
}
DEVI float sigmoidf_(float x) { return __builtin_amdgcn_rcpf(1.f + __builtin_amdgcn_exp2f(-1.4426950408889634f * x)); }
DEVI float log2_sigmoid(float x) { return -log1pf(__expf(-x)) * 1.4426950408889634f; }
DEVI float fexp2(float x) { return __builtin_amdgcn_exp2f(x); }
DEVI int fresh_tid() { int t = threadIdx.x; asm volatile("" : "+v"(t)); return t; }
DEVI int crow(int r, int hi) { return (r & 3) + 8 * (r >> 2) + 4 * hi; }
#define MFMA32(a, b, c) __builtin_amdgcn_mfma_f32_32x32x16_bf16((a), (b), (c), 0, 0, 0)

namespace pg8 {
constexpr int BM = 256, BK = 64, HALF = 128, HTB = HALF * BK * 2, STAGE_BYTES = 8 * HTB, NXCD = 8, WGM = 8;
__host__ __device__ __forceinline__ int lds_byte(int r, int c) { const int st = (r >> 4) * 2 + (c >> 5), rr = r & 15, cc = c & 31, ob = rr * 64 + cc * 2; return st * 1024 + (ob ^ (((ob >> 9) & 1) << 5)); }
__host__ __device__ __forceinline__ void stage_rc(int b, int& R, int& C) { const int st = b / 1024, sb = b % 1024, swz = sb ^ (((sb >> 9) & 1) << 5); R = (st >> 1) * 16 + swz / 64; C = (st & 1) * 32 + (swz % 64) / 2; }
__host__ __device__ __forceinline__ int perm32(int rho) { const int n = rho >> 4, i = rho & 15; return 8 * (i >> 2) + 4 * n + (i & 3); }
struct Unit { int pm, pn; };
struct Gemm { const bf16_t* A; int lda; const bf16_t* Bt; int K; };
struct StaticOrder {
    int nM, nN, nwg, G, c; const unsigned* ready; unsigned need;
    int nextra;
    __device__ void init(int M, int N, int G_, int c_) { nM = M / BM; nN = N / BM; nwg = nM * nN; G = G_; c = c_; ready = nullptr; need = 0u; nextra = 0; }
    __device__ bool next(int i, Unit& u) const {
        const long L = (long)i * G + c;
        if (L >= nwg) { const int j = (int)(L - nwg); if (j >= nextra) return false;
            const int k = j >> 3; u.pm = 64 + (j & 7); u.pn = k < 2 ? 4 + k : (k < 4 ? 8 + k : 12 + k); return true; }
        int wgid = (int)L; { const int q = nwg / NXCD, r = nwg % NXCD, xcd = wgid % NXCD, off = wgid / NXCD; wgid = (xcd < r ? xcd * (q + 1) : r * (q + 1) + (xcd - r) * q) + off; }
        const int nig = WGM * nN, gid = wgid / nig, fm = gid * WGM, gsz = (nM - fm) < WGM ? (nM - fm) : WGM;
        u.pm = fm + ((wgid % nig) % gsz); u.pn = (wgid % nig) / gsz; return true;
    }
    __device__ __forceinline__ void a_ready(const Unit& u) const {
        if (ready) {
            if (threadIdx.x < 64) {

                while ((unsigned)__builtin_amdgcn_readfirstlane(__hip_atomic_load(ready + 64 * u.pm, __ATOMIC_RELAXED, __HIP_MEMORY_SCOPE_AGENT)) < need) {
                    __builtin_amdgcn_s_sleep(2); }
                __builtin_amdgcn_fence(__ATOMIC_ACQUIRE, "agent");
                asm volatile("s_waitcnt vmcnt(0)" ::: "memory");
            }
            asm volatile("" ::: "memory"); __builtin_amdgcn_s_barrier(); asm volatile("" ::: "memory");
        }
    }
    __device__ __forceinline__ void done(const Unit&) const {}
};
struct ChainOrder {
    int nN, nLat, G, c, nctx, c0, nl; const unsigned* ready; unsigned need; unsigned* pub;
    __device__ void init(int nN_, int G_, int c_, int nctx_, int c0_, const unsigned* ready_, unsigned need_, unsigned* pub_) {
        nN = nN_; nLat = 64 * nN_; G = G_; c = c_; nctx = nctx_; c0 = c0_; ready = ready_; need = need_; pub = pub_; nl = c_ < nLat ? (nLat - c_ + G_ - 1) / G_ : 0; }
    __device__ bool next(int i, Unit& u) const {
        if (i < nl) {
            int wgid = i * G + c; { const int q = nLat / NXCD, xcd = wgid % NXCD, off = wgid / NXCD; wgid = xcd * q + off; }
            const int nig = WGM * nN; u.pm = (wgid / nig) * WGM + (wgid % nig) % WGM; u.pn = (wgid % nig) / WGM; return true;
        }
        if (i == nl && c >= c0 && c < c0 + nctx) { const int j = c - c0; u.pm = 64 + (j & 7); u.pn = j >> 3; return true; }
        return false;
    }
    __device__ __forceinline__ void a_ready(const Unit& u) const {
        if (ready) {
            if (threadIdx.x < 64) {

                while ((unsigned)__builtin_amdgcn_readfirstlane(__hip_atomic_load(ready + 64 * u.pm, __ATOMIC_RELAXED, __HIP_MEMORY_SCOPE_AGENT)) < need) {
                    __builtin_amdgcn_s_sleep(2); }
                __builtin_amdgcn_fence(__ATOMIC_ACQUIRE, "agent");
                asm volatile("s_waitcnt vmcnt(0)" ::: "memory");
            }
            asm volatile("" ::: "memory"); __builtin_amdgcn_s_barrier(); asm volatile("" ::: "memory");
        }
    }
    __device__ __forceinline__ void done(const Unit& u) const {
        if (pub) {
            asm volatile("s_waitcnt vmcnt(0)" ::: "memory"); __builtin_amdgcn_s_barrier(); asm volatile("" ::: "memory");
            if (threadIdx.x < 64) {
                __builtin_amdgcn_fence(__ATOMIC_RELEASE, "agent"); asm volatile("s_waitcnt vmcnt(0)" ::: "memory");
                if (threadIdx.x == 0) __hip_atomic_fetch_add(pub + 64 * u.pm, 1u, __ATOMIC_RELAXED, __HIP_MEMORY_SCOPE_AGENT);
            }
        }
    }
};
template <class Epi, class Sched>
__device__ __forceinline__ void gemm_phase(LAS unsigned char* lds, const Gemm g, const Sched& S, const Epi& E) {
    const int tid = fresh_tid();
    const int wid = __builtin_amdgcn_readfirstlane(tid >> 6), lane = tid & 63, wr = wid >> 2, wc = wid & 3, fr = lane & 15, fq = lane >> 4;
    const int K = g.K, nt = K / BK, lda = g.lda;
    unsigned voffA[2], voffB[2];
#pragma unroll
    for (int i = 0; i < 2; ++i) { int R, C; stage_rc(tid * 16 + i * 8192, R, C); const int Rb = (R & ~31) + perm32(R & 31);
        voffA[i] = (unsigned)(R * lda + C) * 2u; voffB[i] = (unsigned)(Rb * K + C) * 2u; }
    const size_t kstep = (size_t)(BK * 2);
    const size_t hstepA = (size_t)HALF * lda * 2, hstepB = (size_t)HALF * K * 2;
    const size_t tstepA = 2 * hstepA, tstepB = 2 * hstepB;
    const unsigned ldsw = (unsigned)wid * 1024u;
    const int aoff = lds_byte(wr * 64 + fr, fq * 8), boff = lds_byte(wc * 32 + fr, fq * 8);
#define PG8_SA(b, h) (((b) * 2 + (h)) * HTB)
#define PG8_SB(b, h) ((4 + (b) * 2 + (h)) * HTB)
#define PG8_STAGE(bufoff, gbase, voff) do { _Pragma("unroll") for (int _i = 0; _i < 2; ++_i) \
        __builtin_amdgcn_global_load_lds((const unsigned*)((const char*)(gbase) + (voff)[_i]), (LAS unsigned*)(lds + (bufoff) + ldsw + _i * 8192), 16, 0, 0); } while (0)
#define PG8_LDA(dst, b, h) do { _Pragma("unroll") for (int m = 0; m < 4; ++m) _Pragma("unroll") for (int k = 0; k < 2; ++k) dst[m][k] = *(const LAS bf16x8*)(lds + PG8_SA(b, h) + aoff + m * 2048 + k * 1024); } while (0)
#define PG8_LDB(dst, b, h) do { _Pragma("unroll") for (int n = 0; n < 2; ++n) _Pragma("unroll") for (int k = 0; k < 2; ++k) dst[n][k] = *(const LAS bf16x8*)(lds + PG8_SB(b, h) + boff + n * 2048 + k * 1024); } while (0)
#define PG8_MMA(ai, bj, At, Bt) do { __builtin_amdgcn_s_setprio(1); _Pragma("unroll") for (int m = 0; m < 4; ++m) _Pragma("unroll") for (int n = 0; n < 2; ++n) _Pragma("unroll") for (int k = 0; k < 2; ++k) \
        acc[ai][bj][m][n] = __builtin_amdgcn_mfma_f32_16x16x32_bf16(Bt[n][k], At[m][k], acc[ai][bj][m][n], 0, 0, 0); __builtin_amdgcn_s_setprio(0); } while (0)
#define PG8_WAIT_V(n) asm volatile("s_waitcnt vmcnt(" #n ")" ::: "memory")
#define PG8_WAIT_L(n) asm volatile("s_waitcnt lgkmcnt(" #n ")" ::: "memory")
#define PG8_BAR __builtin_amdgcn_s_barrier()
#define PG8_SCHED __builtin_amdgcn_sched_barrier(0)
    Unit cur, nxt; int ui = 0;
    if (!S.next(0, cur)) return;
    f32x4 acc[2][2][4][2];
#pragma unroll
    for (int a = 0; a < 2; ++a)
#pragma unroll
        for (int b = 0; b < 2; ++b)
#pragma unroll
            for (int m = 0; m < 4; ++m)
#pragma unroll
                for (int n = 0; n < 2; ++n) acc[a][b][m][n] = (f32x4){0.f, 0.f, 0.f, 0.f};
    bf16x8 At[4][2], B0[2][2], B1[2][2];
    const char* cA = (const char*)g.A + (size_t)cur.pm * tstepA; const char* cB = (const char*)g.Bt + (size_t)cur.pn * tstepB;
    S.a_ready(cur);
    PG8_STAGE(PG8_SB(0, 0), cB, voffB); PG8_STAGE(PG8_SB(0, 1), cB + hstepB, voffB); PG8_STAGE(PG8_SA(0, 0), cA, voffA); PG8_STAGE(PG8_SA(0, 1), cA + hstepA, voffA);
    if (wr == 1) PG8_BAR;
    PG8_WAIT_V(2); PG8_BAR;
    PG8_STAGE(PG8_SB(1, 0), cB + kstep, voffB); PG8_STAGE(PG8_SA(1, 0), cA + kstep, voffA); PG8_STAGE(PG8_SB(1, 1), cB + hstepB + kstep, voffB);
    PG8_WAIT_V(6); PG8_BAR;
    for (;;) {
        const bool has_next = S.next(ui + 1, nxt);
        const char* nA = has_next ? (const char*)g.A + (size_t)nxt.pm * tstepA : cA; const char* nB = has_next ? (const char*)g.Bt + (size_t)nxt.pn * tstepB : cB;
        for (int t = 0; t < nt; t += 2) {
            const bool last = (t == nt - 2);
            const char* a1 = cA + (size_t)(t + 1) * kstep;
            const char* a2 = last ? nA : cA + (size_t)(t + 2) * kstep; const char* b2 = last ? nB : cB + (size_t)(t + 2) * kstep;
            const char* a3 = a2 + kstep; const char* b3 = b2 + kstep;
            if (last && has_next) S.a_ready(nxt);
            PG8_LDB(B0, 0, 0); PG8_LDB(B1, 0, 1); PG8_SCHED; PG8_LDA(At, 0, 0); PG8_STAGE(PG8_SA(1, 1), a1 + hstepA, voffA);
            PG8_WAIT_V(8); PG8_WAIT_L(0); PG8_BAR; PG8_MMA(0, 0, At, B0); PG8_MMA(0, 1, At, B1); PG8_BAR; PG8_SCHED;
            PG8_LDA(At, 0, 1); PG8_STAGE(PG8_SB(0, 0), b2, voffB); PG8_STAGE(PG8_SB(0, 1), b2 + hstepB, voffB); PG8_STAGE(PG8_SA(0, 0), a2, voffA);
            PG8_WAIT_V(8); PG8_WAIT_L(0); PG8_BAR; PG8_MMA(1, 0, At, B0); PG8_MMA(1, 1, At, B1); PG8_BAR; PG8_SCHED;
            PG8_LDB(B0, 1, 0); PG8_LDB(B1, 1, 1); PG8_SCHED; PG8_LDA(At, 1, 0); PG8_STAGE(PG8_SA(0, 1), a2 + hstepA, voffA);
            PG8_WAIT_V(8); PG8_WAIT_L(0); PG8_BAR; PG8_MMA(0, 0, At, B0); PG8_MMA(0, 1, At, B1); PG8_BAR; PG8_SCHED;
            PG8_LDA(At, 1, 1); PG8_STAGE(PG8_SB(1, 0), b3, voffB); PG8_STAGE(PG8_SB(1, 1), b3 + hstepB, voffB); PG8_STAGE(PG8_SA(1, 0), a3, voffA);
            PG8_WAIT_V(8); PG8_WAIT_L(0); PG8_BAR; PG8_MMA(1, 0, At, B0); PG8_MMA(1, 1, At, B1); PG8_BAR; PG8_SCHED;
        }
        if (wr == 0) PG8_BAR;
        { int fr_e = fr, fq_e = fq; asm volatile("" : "+v"(fr_e), "+v"(fq_e));
          E(acc, cur, wr, wc, fr_e, fq_e); }
        S.done(cur);
        if (!has_next) break;
#pragma unroll
        for (int a = 0; a < 2; ++a)
#pragma unroll
            for (int b = 0; b < 2; ++b)
#pragma unroll
                for (int m = 0; m < 4; ++m)
#pragma unroll
                    for (int n = 0; n < 2; ++n) acc[a][b][m][n] = (f32x4){0.f, 0.f, 0.f, 0.f};
        cur = nxt; cA = nA; cB = nB; ++ui;
        if (wr == 1) PG8_BAR;
    }
    PG8_WAIT_V(0);
    PG8_BAR;
#undef PG8_SA
#undef PG8_SB
#undef PG8_STAGE
#undef PG8_LDA
#undef PG8_LDB
#undef PG8_MMA
}

DEVI void store8(bf16_t* p, const f32x4 a, const f32x4 b) {
    u32x4 w; w.x = cvt_pk_bf16(a[0], a[1]); w.y = cvt_pk_bf16(a[2], a[3]); w.z = cvt_pk_bf16(b[0], b[1]); w.w = cvt_pk_bf16(b[2], b[3]); *(u32x4*)p = w;
}
DEVI float row_rstd(const float* stats, int row) {
    const f32x4* sp = (const f32x4*)(stats + (size_t)row * 16);
    const f32x4 a = sp[0], b = sp[1], c = sp[2], d = sp[3];
    const float s = ((a[0] + a[1]) + (a[2] + a[3])) + ((b[0] + b[1]) + (b[2] + b[3])) + ((c[0] + c[1]) + (c[2] + c[3])) + ((d[0] + d[1]) + (d[2] + d[3]));
    return rsqrtf(s * (1.f / DM) + EPS);
}

DEVI void unit_rstd(const float* stats, int pm, LAS float* rsl, int wr, int wc, int fr, int fq, int tag) {
    volatile LAS int* tagw = (volatile LAS int*)(rsl + 256);
    if (__builtin_amdgcn_readfirstlane(tagw[0]) == tag) return;
    const int t = (wr * 4 + wc) * 64 + fq * 16 + fr, row = t >> 1, hf = t & 1;
    const f32x4* sp = (const f32x4*)(stats + (size_t)(pm * 256 + row) * 16 + hf * 8);
    const f32x4 a = sp[0], b = sp[1];
    float s = ((a[0] + a[1]) + (a[2] + a[3])) + ((b[0] + b[1]) + (b[2] + b[3]));
    s += __shfl_xor(s, 1);
    if (hf == 0) rsl[row] = rsqrtf(s * (1.f / DM) + EPS);
    asm volatile("s_waitcnt lgkmcnt(0)" ::: "memory"); __builtin_amdgcn_s_barrier(); asm volatile("" ::: "memory");
    if (t == 0) tagw[0] = tag;
}
struct EpiIn {
    bf16_t* U; const float* stats; const float* bias; const float* qn_g; const float* kn_g; const float* csh; const float* csr;
    bf16_t* KT; bf16_t* VT; const float* ret_logit; LAS float* xch; LAS float* rsl;
    __device__ __forceinline__ void operator()(f32x4 (&acc)[2][2][4][2], const Unit& u, int wr, int wc, int fr, int fq) const {
        const int pm = u.pm, pn = u.pn;
        const bool lat = pm < 64;
        const int rmod = lat ? (pm >> 3) : 8, bb = lat ? (pm >> 3) : (pm - 64);
        const int pos0 = (pm & 7) * 256, tau0 = lat ? 256 + pos0 : 0;
        const int rowt0 = wr * 64 + fr, w8 = wc * 32 + 8 * fq;
        const bool perm = (pn <= 4) || (pn >= 6 && pn <= 10);
        int cb[2];
#pragma unroll
        for (int bj = 0; bj < 2; ++bj) cb[bj] = perm ? ((w8 >> 6) * 128 + bj * 64 + (w8 & 63)) : (bj * 128 + w8);
        unit_rstd(stats, pm, rsl, wr, wc, fr, fq, (int)(unsigned)(uintptr_t)bias + pm);
        {
            const float* bp = bias + (size_t)rmod * NIN + pn * 256;
            f32x4 bv[2][2];
#pragma unroll
            for (int bj = 0; bj < 2; ++bj)
#pragma unroll
                for (int n = 0; n < 2; ++n) bv[bj][n] = *(const f32x4*)(bp + cb[bj] + 4 * n);
#pragma unroll
            for (int ai = 0; ai < 2; ++ai)
#pragma unroll
                for (int m = 0; m < 4; ++m) {
                    const float rs = rsl[ai * 128 + rowt0 + 16 * m];
#pragma unroll
                    for (int bj = 0; bj < 2; ++bj)
#pragma unroll
                        for (int n = 0; n < 2; ++n) acc[ai][bj][m][n] = acc[ai][bj][m][n] * rs + bv[bj][n];
                }
        }
        bf16_t* Ub = U + (size_t)(pm * 256) * LDU + pn * 256;
        const bool norm = perm && (pn <= 4);
        const bool rope128 = perm, rope256 = (pn >= 12 && pn <= 19), rope = (rope128 || rope256) && lat;
        f32x4 g1[2], g2[2];
        if (norm) {
#pragma unroll
            for (int ai = 0; ai < 2; ++ai)
#pragma unroll
                for (int m = 0; m < 4; ++m) {
                    float s = 0.f;
#pragma unroll
                    for (int bj = 0; bj < 2; ++bj)
#pragma unroll
                        for (int n = 0; n < 2; ++n) { const f32x4 x = acc[ai][bj][m][n]; s += (x[0] * x[0] + x[1] * x[1]) + (x[2] * x[2] + x[3] * x[3]); }
                    s += __shfl_xor(s, 16); s += __shfl_xor(s, 32);
                    if (fq == 0) xch[(ai * 128 + rowt0 + 16 * m) * 4 + wc] = s;
                }
            asm volatile("s_waitcnt lgkmcnt(0)" ::: "memory"); __builtin_amdgcn_s_barrier(); asm volatile("" ::: "memory");
            const float* g = (pn < 4) ? qn_g : kn_g;
            const int dd0 = w8 & 63;
#pragma unroll
            for (int n = 0; n < 2; ++n) { g1[n] = *(const f32x4*)(g + dd0 + 4 * n); g2[n] = *(const f32x4*)(g + 64 + dd0 + 4 * n); }
        }
        const float* tab = rope128 ? csh : csr; const int tw = rope128 ? 64 : 128; const int i0 = rope128 ? (w8 & 63) : w8;
        const int kind = (pn >= 16 && pn <= 19) ? 1 : (pn >= 20 && pn <= 27) ? 2 : (pn >= 36) ? 4 : (pn >= 28) ? 3 : 0;
        float lgf = 0.f, lgb = 0.f; bf16_t* t0p = nullptr; bf16_t* t1p = nullptr;
        if (kind == 1) { const int h = pn - 16; lgf = log2_sigmoid(ret_logit[h]); lgb = log2_sigmoid(ret_logit[4 + h]);
            t0p = KT + ((size_t)((0 * NB + bb) * 4 + h) * 256) * TAU + wc * 4096 + fq * 64; t1p = KT + ((size_t)((1 * NB + bb) * 4 + h) * 256) * TAU + wc * 4096 + fq * 64; }
        if (kind == 2) { const int h = (pn - 20) >> 1, e0 = ((pn - 20) & 1) * 256; t0p = VT + ((size_t)(bb * 4 + h) * 512 + e0 + w8) * TAU + tau0; }
        f32x4 tcur[4], tnxt[4];
        if (rope) { const float* tp = tab + ((size_t)(pos0 + rowt0) * tw + i0) * 2;
#pragma unroll
            for (int j = 0; j < 4; ++j) tcur[j] = *(const f32x4*)(tp + 4 * j); }
#pragma unroll
        for (int ai = 0; ai < 2; ++ai)
#pragma unroll
            for (int m = 0; m < 4; ++m) {
                const int rt = ai * 128 + rowt0 + 16 * m;
                if (rope && (ai * 4 + m) < 7) { const int rtn = ((ai * 4 + m + 1) >> 2) * 128 + rowt0 + 16 * ((ai * 4 + m + 1) & 3); const float* tp = tab + ((size_t)(pos0 + rtn) * tw + i0) * 2;
#pragma unroll
                    for (int j = 0; j < 4; ++j) tnxt[j] = *(const f32x4*)(tp + 4 * j); }
                f32x4 v[2][2];
#pragma unroll
                for (int bj = 0; bj < 2; ++bj)
#pragma unroll
                    for (int n = 0; n < 2; ++n) v[bj][n] = acc[ai][bj][m][n];
                if (norm) {
                    const float tot = xch[rt * 4 + wc] + xch[rt * 4 + (wc ^ 1)];
                    const float hr = rsqrtf(tot * (1.f / 128.f) + EPS);
#pragma unroll
                    for (int n = 0; n < 2; ++n) { v[0][n] = v[0][n] * hr * g1[n]; v[1][n] = v[1][n] * hr * g2[n]; }
                }
                if (rope) {
#pragma unroll
                    for (int n = 0; n < 2; ++n) {
                        const f32x4 ta = tcur[2 * n], tb = tcur[2 * n + 1];
                        const f32x4 x1 = v[0][n], x2 = v[1][n];
                        v[0][n][0] = x1[0] * ta[0] - x2[0] * ta[1]; v[1][n][0] = x1[0] * ta[1] + x2[0] * ta[0];
                        v[0][n][1] = x1[1] * ta[2] - x2[1] * ta[3]; v[1][n][1] = x1[1] * ta[3] + x2[1] * ta[2];
                        v[0][n][2] = x1[2] * tb[0] - x2[2] * tb[1]; v[1][n][2] = x1[2] * tb[1] + x2[2] * tb[0];
                        v[0][n][3] = x1[3] * tb[2] - x2[3] * tb[3]; v[1][n][3] = x1[3] * tb[3] + x2[3] * tb[2];
                    }
                }
                if (kind == 1) {
                    const int sidx = (tau0 + rt) & 127;
                    const size_t okt = (size_t)((tau0 + rt) >> 7) * 32768 + (sidx >> 4) * 512 + ((sidx >> 3) & 1) * 256 + (sidx & 7);
                    const float df = fexp2((float)(127 - sidx) * lgf), db = fexp2((float)sidx * lgb);
#pragma unroll
                    for (int bj = 0; bj < 2; ++bj)
#pragma unroll
                        for (int n = 0; n < 2; ++n) {
                            v[bj][n] = v[bj][n] * 0.0625f;
#pragma unroll
                            for (int i = 0; i < 4; ++i) { const size_t o = okt + bj * 16384 + (4 * n + i) * 8; t0p[o] = f2bf(v[bj][n][i] * df); t1p[o] = f2bf(v[bj][n][i] * db); }
                        }
                } else if (kind == 2) {
#pragma unroll
                    for (int bj = 0; bj < 2; ++bj)
#pragma unroll
                        for (int n = 0; n < 2; ++n)
#pragma unroll
                            for (int i = 0; i < 4; ++i) t0p[(size_t)(bj * 128 + 4 * n + i) * TAU + rt] = f2bf(v[bj][n][i]);
                } else if (kind >= 3) {
#pragma unroll
                    for (int bj = 0; bj < 2; ++bj)
#pragma unroll
                        for (int n = 0; n < 2; ++n)
#pragma unroll
                            for (int i = 0; i < 4; ++i) { const float sg = sigmoidf_(v[bj][n][i]); v[bj][n][i] = (kind == 3) ? v[bj][n][i] * sg : sg; }
                }
                if (kind != 2) {
                    const int r0s = (kind == 1) ? (rt & ~31) + (cb[0] >> 3) : rt, c0s = (kind == 1) ? (rt & 31) * 8 : cb[0];
                    const int r1s = (kind == 1) ? r0s + 16 : rt, c1s = (kind == 1) ? c0s : cb[1];
                    store8(Ub + (size_t)r0s * LDU + c0s, v[0][0], v[0][1]);
                    store8(Ub + (size_t)r1s * LDU + c1s, v[1][0], v[1][1]);
                }
                if (rope) {
#pragma unroll
                    for (int j = 0; j < 4; ++j) tcur[j] = tnxt[j]; }
                asm volatile("" ::: "memory");
            }
    }
};

struct EpiRes {
    const float* Xin; float* Xout; const float* gate; const float* ng; const float* sc; bf16_t* Ap; float* stats;
    __device__ __forceinline__ void operator()(f32x4 (&acc)[2][2][4][2], const Unit& u, int wr, int wc, int fr, int fq) const {
        const int pm = u.pm, pn = u.pn;
        const int rmod = pm < 64 ? (pm >> 3) : 8;
        const int rowt0 = wr * 64 + fr, w8 = wc * 32 + 8 * fq;
        f32x4 gt[2][2], gm[2][2];
#pragma unroll
        for (int bj = 0; bj < 2; ++bj)
#pragma unroll
            for (int n = 0; n < 2; ++n) {
                const int col = pn * 256 + bj * 128 + w8 + 4 * n;
                gt[bj][n] = *(const f32x4*)(gate + (size_t)rmod * NMOD + col);
                if (ng) { const f32x4 a = *(const f32x4*)(ng + col), b = *(const f32x4*)(sc + (size_t)rmod * NMOD + col); gm[bj][n] = a * (b + 1.0f); }
                else gm[bj][n] = (f32x4){0.f, 0.f, 0.f, 0.f};
            }
        f32x4 xc[4], xn[4];
        {   const size_t off = ((size_t)pm * 256 + rowt0) * DM + pn * 256 + w8;
            xc[0] = *(const f32x4*)(Xin + off); xc[1] = *(const f32x4*)(Xin + off + 4); xc[2] = *(const f32x4*)(Xin + off + 128); xc[3] = *(const f32x4*)(Xin + off + 132); }
#pragma unroll
        for (int ai = 0; ai < 2; ++ai)
#pragma unroll
            for (int m = 0; m < 4; ++m) {
                const size_t row = (size_t)pm * 256 + ai * 128 + rowt0 + 16 * m;
                if (ai * 4 + m < 7) {
                    const size_t rown = (size_t)pm * 256 + ((ai * 4 + m + 1) >> 2) * 128 + rowt0 + 16 * ((ai * 4 + m + 1) & 3);
                    const size_t off = rown * DM + pn * 256 + w8;
                    xn[0] = *(const f32x4*)(Xin + off); xn[1] = *(const f32x4*)(Xin + off + 4); xn[2] = *(const f32x4*)(Xin + off + 128); xn[3] = *(const f32x4*)(Xin + off + 132); }
                float ss = 0.f;
#pragma unroll
                for (int bj = 0; bj < 2; ++bj) {
                    const size_t off = row * DM + pn * 256 + bj * 128 + w8;
                    f32x4 x0 = xc[2 * bj], x1 = xc[2 * bj + 1];
                    x0 = x0 + gt[bj][0] * acc[ai][bj][m][0]; x1 = x1 + gt[bj][1] * acc[ai][bj][m][1];
                    *(f32x4*)(Xout + off) = x0; *(f32x4*)(Xout + off + 4) = x1;
                    ss += ((x0[0] * x0[0] + x0[1] * x0[1]) + (x0[2] * x0[2] + x0[3] * x0[3])) + ((x1[0] * x1[0] + x1[1] * x1[1]) + (x1[2] * x1[2] + x1[3] * x1[3]));
                    if (ng) store8(Ap + off, x0 * gm[bj][0], x1 * gm[bj][1]);
                }
                ss += __shfl_xor(ss, 16); ss += __shfl_xor(ss, 32);
                if (fq == 0) stats[row * 16 + pn * 4 + wc] = ss;
#pragma unroll
                for (int j = 0; j < 4; ++j) xc[j] = xn[j];
                asm volatile("" ::: "memory");
            }
    }
};

struct EpiFfn1 {
    bf16_t* H; const float* stats; const float* bias; LAS float* rsl;
    __device__ __forceinline__ void operator()(f32x4 (&acc)[2][2][4][2], const Unit& u, int wr, int wc, int fr, int fq) const {
        const int pm = u.pm, pn = u.pn;
        const int rmod = pm < 64 ? (pm >> 3) : 8;
        const int rowt0 = wr * 64 + fr, w8 = wc * 32 + 8 * fq;
        unit_rstd(stats, pm, rsl, wr, wc, fr, fq, (int)(unsigned)(uintptr_t)bias + pm);
        f32x4 bv[2][2];
#pragma unroll
        for (int bj = 0; bj < 2; ++bj)
#pragma unroll
            for (int n = 0; n < 2; ++n) bv[bj][n] = *(const f32x4*)(bias + (size_t)rmod * DFF + pn * 256 + bj * 128 + w8 + 4 * n);
#pragma unroll
        for (int ai = 0; ai < 2; ++ai)
#pragma unroll
            for (int m = 0; m < 4; ++m) {
                const size_t row = (size_t)pm * 256 + ai * 128 + rowt0 + 16 * m;
                const float rs = rsl[ai * 128 + rowt0 + 16 * m];
#pragma unroll
                for (int bj = 0; bj < 2; ++bj) {
                    f32x4 v0 = acc[ai][bj][m][0] * rs + bv[bj][0], v1 = acc[ai][bj][m][1] * rs + bv[bj][1];
#pragma unroll
                    for (int i = 0; i < 4; ++i) { v0[i] = fmaxf(v0[i], 0.f); v0[i] *= v0[i]; v1[i] = fmaxf(v1[i], 0.f); v1[i] *= v1[i]; }
                    store8(H + row * LDU + pn * 256 + bj * 128 + w8, v0, v1);
                }
            }
    }
};

template <int ACCUM> struct EpiMerge1 {
    bf16_t* U; int goff;
    __device__ __forceinline__ void operator()(f32x4 (&acc)[2][2][4][2], const Unit& u, int wr, int wc, int fr, int fq) const {
        const int pm = u.pm, pn = u.pn;
        const int rowt0 = wr * 64 + fr, w8 = wc * 32 + 8 * fq;
#pragma unroll
        for (int ai = 0; ai < 2; ++ai)
#pragma unroll
            for (int m = 0; m < 4; ++m) {
                const size_t row = (size_t)pm * 256 + ai * 128 + rowt0 + 16 * m;
#pragma unroll
                for (int bj = 0; bj < 2; ++bj) {
                    const int col = pn * 256 + bj * 128 + w8;
                    const u32x4 gw = *(const u32x4*)(U + row * LDU + goff + col);
                    f32x4 v0, v1;
                    v0[0] = bf_lo(gw.x) * acc[ai][bj][m][0][0]; v0[1] = bf_hi(gw.x) * acc[ai][bj][m][0][1]; v0[2] = bf_lo(gw.y) * acc[ai][bj][m][0][2]; v0[3] = bf_hi(gw.y) * acc[ai][bj][m][0][3];
                    v1[0] = bf_lo(gw.z) * acc[ai][bj][m][1][0]; v1[1] = bf_hi(gw.z) * acc[ai][bj][m][1][1]; v1[2] = bf_lo(gw.w) * acc[ai][bj][m][1][2]; v1[3] = bf_hi(gw.w) * acc[ai][bj][m][1][3];
                    bf16_t* yp = U + row * LDU + YOFF + col;
                    if (ACCUM) { const u32x4 pw = *(const u32x4*)yp;
                        v0[0] += bf_lo(pw.x); v0[1] += bf_hi(pw.x); v0[2] += bf_lo(pw.y); v0[3] += bf_hi(pw.y); v1[0] += bf_lo(pw.z); v1[1] += bf_hi(pw.z); v1[2] += bf_lo(pw.w); v1[3] += bf_hi(pw.w); }
                    store8(yp, v0, v1);
                }
            }
    }
};
}

namespace att {
constexpr int D = 128, NW = 8, QBLK = 32, KVBLK = 64;
constexpr float SCALE = 0.088388347648318440f;
constexpr float THR = 8.f;
constexpr size_t SHM_V = KVBLK * D * 2, SHM_K = KVBLK * D * 2, SHM_ATTN = 2 * SHM_V + 2 * SHM_K + NW * 64 * 4;
#define KSWZ(row, colB) ((row) * 256 + ((colB) ^ (((row) & 7) << 4)))
#define SBAR() __builtin_amdgcn_sched_barrier(0)
struct AUnit { const bf16_t* Q; bf16_t* O; const bf16_t* K; const bf16_t* V; int base1, n1, base2, NT; int mask, q0pos, k0pos; float m0, l0; };
DEVI void partialSM(f32x16& p0, f32x16& p1, float& m_reg, float& mn, float& alpha) {
    constexpr float C = SCALE * 1.4426950408889634f;
    float pmax = p0[0];
#pragma unroll
    for (int r = 1; r < 16; ++r) pmax = fmaxf(pmax, p0[r]);
#pragma unroll
    for (int r = 0; r < 16; ++r) pmax = fmaxf(pmax, p1[r]);
    { auto rr = __builtin_amdgcn_permlane32_swap(__float_as_uint(pmax), __float_as_uint(pmax), false, false);
      pmax = fmaxf(__uint_as_float(rr[0]), __uint_as_float(rr[1])); }
    if (__builtin_expect(__all(pmax - m_reg <= THR / SCALE), 1)) { mn = m_reg; alpha = 1.f; }
    else { mn = fmaxf(m_reg, pmax); alpha = __builtin_amdgcn_exp2f((m_reg - mn) * C); m_reg = mn; }
    const float mnC = -mn * C;
#pragma unroll
    for (int r = 0; r < 16; ++r) p0[r] = fmaf(p0[r], C, mnC);
#pragma unroll
    for (int r = 0; r < 16; ++r) p1[r] = fmaf(p1[r], C, mnC);
#pragma unroll
    for (int r = 0; r < 16; ++r) p0[r] = __builtin_amdgcn_exp2f(p0[r]);
}
DEVI void finishSM(f32x16& p0, f32x16& p1, float alpha, float& l_reg, bf16x8& pa0, bf16x8& pa1, bf16x8& pa2, bf16x8& pa3) {
#pragma unroll
    for (int r = 0; r < 16; ++r) p1[r] = __builtin_amdgcn_exp2f(p1[r]);
    float ps = 0;
#pragma unroll
    for (int r = 0; r < 16; ++r) ps += p0[r];
#pragma unroll
    for (int r = 0; r < 16; ++r) ps += p1[r];
    { auto rr = __builtin_amdgcn_permlane32_swap(__float_as_uint(ps), __float_as_uint(ps), false, false);
      ps = __uint_as_float(rr[0]) + __uint_as_float(rr[1]); }
    l_reg = l_reg * alpha + ps;
#define PK4(P, BASE, OUT) do { unsigned a0 = cvt_pk_bf16(P[BASE + 0], P[BASE + 1]), a1 = cvt_pk_bf16(P[BASE + 2], P[BASE + 3]);   \
    unsigned b0 = cvt_pk_bf16(P[BASE + 4], P[BASE + 5]), b1 = cvt_pk_bf16(P[BASE + 6], P[BASE + 7]);                              \
    auto r0 = __builtin_amdgcn_permlane32_swap(a0, b0, false, false); auto r1 = __builtin_amdgcn_permlane32_swap(a1, b1, false, false); \
    u32x4 w = {r0[0], r1[0], r0[1], r1[1]}; OUT = __builtin_bit_cast(bf16x8, w); } while (0)
    PK4(p0, 0, pa0); PK4(p0, 8, pa1); PK4(p1, 0, pa2); PK4(p1, 8, pa3);
#undef PK4
}
DEVI void qkt(f32x16& p0, f32x16& p1, const char* Ks, const bf16x8* qr, int r32, int hi) {
    p0 = f32x16{}; p1 = f32x16{};
#pragma unroll
    for (int d0 = 0; d0 < 8; ++d0) { const int cb = (d0 * 16 + hi * 8) * 2;
        const bf16x8 b0 = *reinterpret_cast<const bf16x8*>(Ks + KSWZ(r32, cb));
        const bf16x8 b1 = *reinterpret_cast<const bf16x8*>(Ks + KSWZ(32 + r32, cb));
        p0 = MFMA32(b0, qr[d0], p0);
        p1 = MFMA32(b1, qr[d0], p1); }
}
DEVI int v_st(int k, int c) { const int kk = (k & ~0xC) | ((k & 4) << 1) | ((k & 8) >> 1); return ((kk >> 3) * 4 + (c >> 5)) * 512 + ((kk & 7) * 32 + (c & 31)) * 2; }
DEVI int v_rd_base(int lane) { return ((lane & 3) << 3) | (((lane >> 2) & 3) << 6) | (((lane >> 4) & 1) << 5) | (((lane >> 5) & 1) << 8); }
constexpr int v_rd_off(int d0, int ks, int half) { return d0 * 512 + ks * 4096 + half * 2048; }
template <int OFF> DEVI s16x4 tr_read(int vb) { s16x4 r; asm volatile("ds_read_b64_tr_b16 %0, %1 offset:%2" : "=&v"(r) : "v"(vb), "i"(OFF) : "memory"); return r; }
template <int D0> DEVI void pv_one(f32x16& od, int vb, bf16x8 pa0, bf16x8 pa1, bf16x8 pa2, bf16x8 pa3) {
    const s16x4 l0 = tr_read<v_rd_off(D0, 0, 0)>(vb), h0 = tr_read<v_rd_off(D0, 0, 1)>(vb), l1 = tr_read<v_rd_off(D0, 1, 0)>(vb), h1 = tr_read<v_rd_off(D0, 1, 1)>(vb);
    const s16x4 l2 = tr_read<v_rd_off(D0, 2, 0)>(vb), h2 = tr_read<v_rd_off(D0, 2, 1)>(vb), l3 = tr_read<v_rd_off(D0, 3, 0)>(vb), h3 = tr_read<v_rd_off(D0, 3, 1)>(vb);
    asm volatile("s_waitcnt lgkmcnt(0)" ::: "memory"); SBAR();
#define PK(L, H) (bf16x8){L[0], L[1], L[2], L[3], H[0], H[1], H[2], H[3]}
    od = MFMA32(pa0, PK(l0, h0), od);
    od = MFMA32(pa1, PK(l1, h1), od);
    od = MFMA32(pa2, PK(l2, h2), od);
    od = MFMA32(pa3, PK(l3, h3), od);
#undef PK
}
DEVI void pv_d0(f32x16* o, int vb, bf16x8 pa0, bf16x8 pa1, bf16x8 pa2, bf16x8 pa3) {
    pv_one<0>(o[0], vb, pa0, pa1, pa2, pa3); pv_one<1>(o[1], vb, pa0, pa1, pa2, pa3); pv_one<2>(o[2], vb, pa0, pa1, pa2, pa3); pv_one<3>(o[3], vb, pa0, pa1, pa2, pa3);
}
DEVI void band_mask(f32x16& p0, f32x16& p1, int qpos, int kt0, int hi) {
#pragma unroll
    for (int r = 0; r < 16; ++r) {
        const int k0 = kt0 + crow(r, hi), d0 = qpos - k0, d1 = d0 - 32;
        if (d0 > 128 || d0 < -128) p0[r] = -INFINITY;
        if (d1 > 128 || d1 < -128) p1[r] = -INFINITY;
    }
}
DEVI void attn_unit(const AUnit& u, char* lds) {
    const int tid = fresh_tid();
    const int wid = tid >> 6, lane = tid & 63, r32 = lane & 31, hi = lane >> 5;
    char* V_lds = lds; char* K_lds = lds + 2 * SHM_V;
    float* ws = (float*)(lds + 2 * SHM_V + 2 * SHM_K) + wid * 64; float* li_l = ws; float* al_l = ws + 32;
    float m_reg = u.m0, l_reg = u.l0; f32x16 o[4] = {}; bf16x8 qr[8];
    const bf16_t* Qw = u.Q + (size_t)(wid * QBLK + r32) * LDU + hi * 8;
#pragma unroll
    for (int d0 = 0; d0 < 8; ++d0) qr[d0] = *reinterpret_cast<const bf16x8*>(Qw + d0 * 16);
    const int sr = tid >> 4, sc = (tid & 15) * 8, vst0 = v_st(sr, sc), vst1 = v_st(32 + sr, sc);
    const int vb0 = (int)(uintptr_t)V_lds + v_rd_base(lane);
    const int qpos = u.q0pos + wid * QBLK + r32;
    struct { bf16x8 vs0, vs1, ks0, ks1; } sr_[2];
#define TROW(t) ((t) < u.n1 ? u.base1 + 64 * (t) : u.base2 + 64 * ((t) - u.n1))
#define SLOAD(i, t) do { const size_t r0_ = (size_t)(TROW(t) + sr) * LDU + sc; \
    sr_[i].vs0 = *reinterpret_cast<const bf16x8*>(u.V + r0_); sr_[i].vs1 = *reinterpret_cast<const bf16x8*>(u.V + r0_ + (size_t)32 * LDU); \
    sr_[i].ks0 = *reinterpret_cast<const bf16x8*>(u.K + r0_); sr_[i].ks1 = *reinterpret_cast<const bf16x8*>(u.K + r0_ + (size_t)32 * LDU); } while (0)
#define SWRITE(b, i) do { *(bf16x8*)(V_lds + (b) * SHM_V + vst0) = sr_[i].vs0;          \
    *(bf16x8*)(V_lds + (b) * SHM_V + vst1) = sr_[i].vs1; const int kc = sc * 2;               \
    *(bf16x8*)(K_lds + (b) * SHM_K + KSWZ(sr, kc)) = sr_[i].ks0;                       \
    *(bf16x8*)(K_lds + (b) * SHM_K + KSWZ(32 + sr, kc)) = sr_[i].ks1; } while (0)
#define SWAIT() asm volatile("s_waitcnt vmcnt(4)" ::: "memory")
#define RESC(a) do { if (__any((a) < 1.f)) { if (hi == 0) al_l[r32] = (a); asm volatile("s_waitcnt lgkmcnt(0)" ::: "memory"); \
    _Pragma("unroll") for (int d = 0; d < 4; ++d) _Pragma("unroll") for (int r = 0; r < 16; ++r) o[d][r] *= al_l[crow(r, hi)]; } } while (0)
#define MASK(P0, P1, t) do { if (u.mask && (t) < u.n1) band_mask(P0, P1, qpos, u.k0pos + 64 * (t), hi); } while (0)
    f32x16 pA0, pA1, pB0, pB1; float mnA, mnB, alA, alB; bf16x8 pa0, pa1, pa2, pa3; const int NT = u.NT;
    constexpr int SE = 0, SO = 1;
    SLOAD(SE, 0); asm volatile("s_waitcnt vmcnt(0)" ::: "memory"); SWRITE(0, SE); __syncthreads();
    qkt(pA0, pA1, K_lds, qr, r32, hi); MASK(pA0, pA1, 0); partialSM(pA0, pA1, m_reg, mnA, alA);
    SLOAD(SO, 1); if (2 < NT) SLOAD(SE, 2);
    if (2 < NT) SWAIT(); else asm volatile("s_waitcnt vmcnt(0)" ::: "memory");
    SWRITE(1, SO); __syncthreads();
    RESC(alA);
    for (int j = 1; j + 1 < NT; j += 2) {
        SBAR(); qkt(pB0, pB1, K_lds + SHM_K, qr, r32, hi); MASK(pB0, pB1, j);
        finishSM(pA0, pA1, alA, l_reg, pa0, pa1, pa2, pa3); SBAR();
        if (j + 2 < NT) SLOAD(SO, j + 2); SBAR();
        pv_d0(o, vb0, pa0, pa1, pa2, pa3); partialSM(pB0, pB1, m_reg, mnB, alB);
        __syncthreads(); if (j + 2 < NT) SWAIT(); else asm volatile("s_waitcnt vmcnt(0)" ::: "memory"); SWRITE(0, SE);
        RESC(alB); __syncthreads();
        SBAR(); qkt(pA0, pA1, K_lds, qr, r32, hi); MASK(pA0, pA1, j + 1);
        finishSM(pB0, pB1, alB, l_reg, pa0, pa1, pa2, pa3); SBAR();
        if (j + 3 < NT) SLOAD(SE, j + 3); SBAR();
        pv_d0(o, vb0 + (int)SHM_V, pa0, pa1, pa2, pa3); partialSM(pA0, pA1, m_reg, mnA, alA);
        __syncthreads(); if (j + 3 < NT) SWAIT(); else asm volatile("s_waitcnt vmcnt(0)" ::: "memory"); SWRITE(1, SO);
        RESC(alA); __syncthreads();
    }
    SBAR(); qkt(pB0, pB1, K_lds + SHM_K, qr, r32, hi); MASK(pB0, pB1, NT - 1);
    finishSM(pA0, pA1, alA, l_reg, pa0, pa1, pa2, pa3); SBAR();
    pv_d0(o, vb0, pa0, pa1, pa2, pa3); partialSM(pB0, pB1, m_reg, mnB, alB);
    __syncthreads(); RESC(alB);
    finishSM(pB0, pB1, alB, l_reg, pa0, pa1, pa2, pa3); SBAR();
    pv_d0(o, vb0 + (int)SHM_V, pa0, pa1, pa2, pa3);
    if (hi == 0) li_l[r32] = l_reg; asm volatile("s_waitcnt lgkmcnt(0)" ::: "memory");
    float rli[16];
#pragma unroll
    for (int r = 0; r < 16; ++r) rli[r] = __builtin_amdgcn_rcpf(li_l[crow(r, hi)]);
    bf16_t* Ow = u.O + (size_t)(wid * QBLK) * LDU;
#pragma unroll
    for (int r = 0; r < 16; ++r) { const int orow = crow(r, hi);
#pragma unroll
        for (int d0 = 0; d0 < 4; ++d0) Ow[(size_t)orow * LDU + d0 * 32 + r32] = f2bf(o[d0][r] * rli[r]); }
    __syncthreads();
#undef TROW
#undef SLOAD
#undef SWRITE
#undef SWAIT
#undef RESC
#undef MASK
}
}

namespace ret {
constexpr int ST_P = 264, VT_P = 136, ATT_P = 136;
constexpr int LDS_ST = 0, LDS_VT = 64 * ST_P * 2, VT_SZ = 64 * VT_P * 2, LDS_Q = LDS_VT + 2 * VT_SZ, LDS_SCAN_BYTES = LDS_Q + 128 * ST_P * 2;
constexpr int LDS_ATT = 0, LDS_XL = 128 * ATT_P * 2, LDS_VS = LDS_XL + 128 * 2 * 4, LDS_INTRA_BYTES = LDS_VS + 256 * ATT_P * 2;
DEVI bf16x8 ld8(const bf16_t* p) { return *reinterpret_cast<const bf16x8*>(p); }
#define RET_GEO(step_, dir_, row_, tau_) do { if ((step_) < 2) { const int j_ = (dir_) ? 1 - (step_) : (step_); row_ = M_LAT + b * CTX + 128 * j_; tau_ = 128 * j_; } \
        else { const int c_ = (dir_) ? 17 - (step_) : (step_) - 2; row_ = b * SEQ + 128 * c_; tau_ = 256 + 128 * c_; } } while (0)
DEVI void scan_unit(int b, int h, int es, bf16_t* U, const bf16_t* KT, const bf16_t* VT, float lgf, float lgb, char* lds, unsigned* done_cnt) {
    const int tid = fresh_tid();
    const int w = __builtin_amdgcn_readfirstlane(tid >> 6), lane = tid & 63;
    bf16_t* st_l = (bf16_t*)(lds + LDS_ST); bf16_t* ql = (bf16_t*)(lds + LDS_Q);
    const bf16_t* VTe = VT + ((size_t)(b * 4 + h) * 512 + es * 64) * TAU;
    const int rb = w >> 1, cb = w & 1;
    const int ve = tid >> 3, vp = (tid & 7) * 16;
    const int ocvB = ((((es >> 1) & 1) * 8) + 4 * (es >> 2) + 2 * (es & 1) + cb) * 2;
    for (int dir = 0; dir < 2; ++dir) {
        const float lg = dir ? lgb : lgf;
        const float cdec = fexp2(128.f * lg);
        const bf16_t* KTd = KT + ((size_t)((dir * NB + b) * 4 + h) * 256) * TAU;
        f32x16 accS[2]; accS[0] = f32x16{}; accS[1] = f32x16{};
        bf16x8 kfA[8], kfB[8], qs[8], vs0, vs1; u32x2 oldA[4], oldB[4];
        {
            int row0, tau0; RET_GEO(0, dir, row0, tau0); (void)row0;
            const int r32 = lane & 31, hi = lane >> 5;
            const bf16_t* kp = KTd + (size_t)(tau0 >> 7) * 32768 + w * 4096 + lane * 8;
#pragma unroll
            for (int k0 = 0; k0 < 8; ++k0) kfA[k0] = ld8(kp + 512 * k0);
            vs0 = ld8(VTe + (size_t)ve * TAU + tau0 + vp); vs1 = ld8(VTe + (size_t)ve * TAU + tau0 + vp + 8);
            bf16_t* vl = (bf16_t*)(lds + LDS_VT) + ve * VT_P + vp;
            *(bf16x8*)vl = vs0; *(bf16x8*)(vl + 8) = vs1;
            __syncthreads();
        }
#define SCAN_STEP(step, KC, KN, OC, ON) do { \
            float lgs = lg; int lane_s = lane; asm volatile("" : "+v"(lgs), "+v"(lane_s)); \
            const int r32 = lane_s & 31, hi = lane_s >> 5; \
            int row0, tau0, row1 = 0, tau1 = 0; RET_GEO(step, dir, row0, tau0); (void)tau0; \
            const bool more = (step) < 17; \
            if (more) RET_GEO((step) + 1, dir, row1, tau1); \
            const bf16_t* vl_cur = (const bf16_t*)(lds + LDS_VT + ((step) & 1) * VT_SZ); \
            bf16_t* vl_nxt = (bf16_t*)(lds + LDS_VT + (((step) + 1) & 1) * VT_SZ); \
            if (more) {     \
                vs0 = ld8(VTe + (size_t)ve * TAU + tau1 + vp); vs1 = ld8(VTe + (size_t)ve * TAU + tau1 + vp + 8); \
                const bf16_t* qg = U + (size_t)row1 * LDU + CQ + h * 256; \
                _Pragma("unroll") for (int j = 0; j < 8; ++j) { const int idx = tid + 512 * j; qs[j] = ld8(qg + (size_t)(idx >> 5) * LDU + 8 * (idx & 31)); } \
                const bf16_t* kp = KTd + (size_t)(tau1 >> 7) * 32768 + w * 4096 + lane_s * 8; \
                _Pragma("unroll") for (int k0 = 0; k0 < 8; ++k0) KN[k0] = ld8(kp + 512 * k0); \
                if (dir) { const bf16_t* op1 = U + (size_t)(row1 + 32 * rb + ocvB) * LDU + CV + h * 512 + lane_s * 4; \
                    _Pragma("unroll") for (int g = 0; g < 4; ++g) ON[g] = *(const u32x2*)(op1 + (size_t)(g >> 1) * LDU + (g & 1) * 256); } \
            } \
            bf16_t* op = U + (size_t)(row0 + 32 * rb + ocvB) * LDU + CV + h * 512 + lane_s * 4; \
            f32x16 acc = f32x16{}; \
            if ((step) > 0) {     \
                const bf16_t* sp = st_l + (32 * cb + r32) * ST_P + 8 * hi; \
                const bf16_t* qp = ql + (32 * rb + r32) * ST_P + 8 * hi; \
                f32x16 acc2 = f32x16{};     \
                _Pragma("unroll") for (int k0 = 0; k0 < 16; k0 += 2) { const bf16x8 a = ld8(sp + 16 * k0), a2 = ld8(sp + 16 * k0 + 16); const bf16x8 bq = ld8(qp + 16 * k0), bq2 = ld8(qp + 16 * k0 + 16); \
                    acc = MFMA32(a, bq, acc); acc2 = MFMA32(a2, bq2, acc2); } \
                _Pragma("unroll") for (int r = 0; r < 16; ++r) acc[r] += acc2[r]; \
                const int qi = 32 * rb + r32; \
                const float sc = fexp2((float)(dir ? 128 - qi : qi + 1) * lgs); \
                _Pragma("unroll") for (int r = 0; r < 16; ++r) acc[r] *= sc; \
            } \
            if (!dir || (step) > 0) { \
                _Pragma("unroll") for (int g = 0; g < 4; ++g) { \
                    float v0 = acc[4 * g], v1 = acc[4 * g + 1], v2 = acc[4 * g + 2], v3 = acc[4 * g + 3]; \
                    if (dir) { v0 += bf_lo(OC[g].x); v1 += bf_hi(OC[g].x); v2 += bf_lo(OC[g].y); v3 += bf_hi(OC[g].y); } \
                    u32x2 pk; pk.x = cvt_pk_bf16(v0, v1); pk.y = cvt_pk_bf16(v2, v3); *(u32x2*)(op + (size_t)(g >> 1) * LDU + (g & 1) * 256) = pk; } \
            } \
            if (more) {     \
                _Pragma("unroll") for (int r = 0; r < 16; ++r) { accS[0][r] *= cdec; accS[1][r] *= cdec; } \
                const bf16_t* vp0 = vl_cur + r32 * VT_P + 8 * hi; \
                _Pragma("unroll") for (int k0 = 0; k0 < 8; ++k0) { const bf16x8 b0 = ld8(vp0 + 16 * k0), b1 = ld8(vp0 + 32 * VT_P + 16 * k0); \
                    accS[0] = MFMA32(KC[k0], b0, accS[0]); accS[1] = MFMA32(KC[k0], b1, accS[1]); } \
            } \
            __syncthreads(); \
            if (more) { \
                _Pragma("unroll") for (int c2 = 0; c2 < 2; ++c2) _Pragma("unroll") for (int g = 0; g < 4; ++g) { \
                    u32x2 pk; pk.x = cvt_pk_bf16_c(accS[c2][4 * g], accS[c2][4 * g + 1]); pk.y = cvt_pk_bf16_c(accS[c2][4 * g + 2], accS[c2][4 * g + 3]); \
                    *(u32x2*)(st_l + (32 * c2 + r32) * ST_P + 32 * w + 8 * g + 4 * hi) = pk; } \
                bf16_t* vl = vl_nxt + ve * VT_P + vp; \
                *(bf16x8*)vl = vs0; *(bf16x8*)(vl + 8) = vs1; \
                _Pragma("unroll") for (int j = 0; j < 8; ++j) { const int idx = tid + 512 * j; *(bf16x8*)(ql + (idx >> 5) * ST_P + 8 * (idx & 31)) = qs[j]; } \
            } \
            __syncthreads(); \
        } while (0)
        for (int pr = 0; pr < 9; ++pr) {
            SCAN_STEP(2 * pr, kfA, kfB, oldA, oldB);
            SCAN_STEP(2 * pr + 1, kfB, kfA, oldB, oldA);
        }
#undef SCAN_STEP
    }
    asm volatile("s_waitcnt vmcnt(0)" ::: "memory"); __syncthreads();
    if (tid < 64) { __builtin_amdgcn_fence(__ATOMIC_RELEASE, "agent"); asm volatile("s_waitcnt vmcnt(0)" ::: "memory");
        if (tid == 0) __hip_atomic_fetch_add(done_cnt, 1u, __ATOMIC_RELAXED, __HIP_MEMORY_SCOPE_AGENT); }
}
DEVI void intra_unit(int b, int h, int ci, bf16_t* U, const bf16_t* VT, const float* gn, float lgf, float lgb, char* lds) {
    const int tid = fresh_tid();
    const int w = __builtin_amdgcn_readfirstlane(tid >> 6), lane = tid & 63, r32 = lane & 31, hi = lane >> 5;
    bf16_t* att_l = (bf16_t*)(lds + LDS_ATT); float* xl = (float*)(lds + LDS_XL);
    int row0, tau0;
    if (ci < 2) { row0 = M_LAT + b * CTX + 128 * ci; tau0 = 128 * ci; } else { row0 = b * SEQ + 128 * (ci - 2); tau0 = 256 + 128 * (ci - 2); }
    const int rb = w >> 1;
    bf16x8 stg0[8];
    {   const bf16_t* vbase0 = VT + ((size_t)(b * 4 + h) * 512) * TAU + tau0;
#pragma unroll
        for (int j = 0; j < 8; ++j) { const int idx = tid + 512 * j, row = idx >> 4, pc = idx & 15; stg0[j] = ld8(vbase0 + (size_t)row * TAU + 8 * pc); } }
    {
        const bf16_t* Qc = U + (size_t)row0 * LDU + CQ + h * 256;
        const bf16_t* Kc = U + (size_t)row0 * LDU + CK + h * 256;
        const int cb0 = 2 * (w & 1);
        f32x16 a0 = f32x16{}, a1 = f32x16{};
        const bf16_t* qp = Qc + (size_t)(32 * rb + r32) * LDU + 8 * hi;
        const bf16_t* kp0 = Kc + (size_t)(cb0 * 32 + hi) * LDU + r32 * 8; const bf16_t* kp1 = kp0 + (size_t)32 * LDU;
#pragma unroll 8
        for (int k0 = 0; k0 < 16; ++k0) {
            const bf16x8 a = ld8(qp + 16 * k0); const bf16x8 b0 = ld8(kp0 + (size_t)(2 * k0) * LDU), b1 = ld8(kp1 + (size_t)(2 * k0) * LDU);
            a0 = MFMA32(a, b0, a0); a1 = MFMA32(a, b1, a1);
        }
#pragma unroll
        for (int r = 0; r < 16; ++r) {
            const int qi = 32 * rb + crow(r, hi);
            const int s0 = 32 * cb0 + r32, s1 = s0 + 32;
            const int d0 = qi - s0, d1 = qi - s1;
            const float f0 = d0 > 0 ? fexp2((float)d0 * lgf) : (d0 < 0 ? fexp2((float)(-d0) * lgb) : 2.f);
            const float f1 = d1 > 0 ? fexp2((float)d1 * lgf) : (d1 < 0 ? fexp2((float)(-d1) * lgb) : 2.f);
            att_l[qi * ATT_P + s0] = f2bf(a0[r] * f0); att_l[qi * ATT_P + s1] = f2bf(a1[r] * f1);
        }
    }
    __syncthreads();
    const int sub = w & 1;
    f32x16 acc[8];
    {
        bf16x8 bfr[8];
        const bf16_t* ap = att_l + (32 * rb + r32) * ATT_P + 8 * hi;
#pragma unroll
        for (int k0 = 0; k0 < 8; ++k0) bfr[k0] = ld8(ap + 16 * k0);
        bf16_t* vt_l = (bf16_t*)(lds + LDS_VS);
        const bf16_t* vbase = VT + ((size_t)(b * 4 + h) * 512) * TAU + tau0;
#pragma unroll
        for (int p = 0; p < 2; ++p) {
            bf16x8 stg[8];
#pragma unroll
            for (int j = 0; j < 8; ++j) { const int idx = tid + 512 * j, row = idx >> 4, pc = idx & 15; stg[j] = p ? ld8(vbase + (size_t)(256 + row) * TAU + 8 * pc) : stg0[j]; }
            if (p) __syncthreads();
#pragma unroll
            for (int j = 0; j < 8; ++j) { const int idx = tid + 512 * j, row = idx >> 4, pc = idx & 15; *(bf16x8*)(vt_l + row * ATT_P + 8 * pc) = stg[j]; }
            __syncthreads();
            const bf16_t* vp = vt_l + (128 * sub + r32) * ATT_P + 8 * hi;
#pragma unroll
            for (int t = 0; t < 4; ++t) {
                f32x16 c = f32x16{};
#pragma unroll
                for (int k0 = 0; k0 < 8; ++k0) { const bf16x8 a = ld8(vp + (32 * t) * ATT_P + 16 * k0); c = MFMA32(a, bfr[k0], c); }
                acc[4 * p + t] = c;
            }
        }
    }
    bf16_t* orow = U + (size_t)(row0 + 32 * rb + r32) * LDU + h * 512 + 128 * sub + 4 * hi;
#define EOFF(t) (256 * ((t) >> 2) + 32 * ((t) & 3))
    float ss = 0.f;
#pragma unroll
    for (int t = 0; t < 8; ++t)
#pragma unroll
        for (int g = 0; g < 4; ++g) {
            const u32x2 ow = *(const u32x2*)(U + (size_t)(row0 + 32 * rb + (sub * 8 + t) * 2 + (g >> 1)) * LDU + CV + h * 512 + (g & 1) * 256 + lane * 4);
            acc[t][4 * g] += bf_lo(ow.x); acc[t][4 * g + 1] += bf_hi(ow.x); acc[t][4 * g + 2] += bf_lo(ow.y); acc[t][4 * g + 3] += bf_hi(ow.y);
#pragma unroll
            for (int i = 0; i < 4; ++i) ss += acc[t][4 * g + i] * acc[t][4 * g + i];
        }
    ss += __shfl_xor(ss, 32);
    if (hi == 0) xl[(32 * rb + r32) * 2 + sub] = ss;
    __syncthreads();
    const float rs = rsqrtf((xl[(32 * rb + r32) * 2] + xl[(32 * rb + r32) * 2 + 1]) * (1.f / 512.f) + EPS);
    const float* gnp = gn + h * 512 + 128 * sub + 4 * hi;
#pragma unroll
    for (int t = 0; t < 8; ++t)
#pragma unroll
        for (int g = 0; g < 4; ++g) {
            bf16_t* gp = orow + CG + EOFF(t) + 8 * g;
            const u32x2 gw = *(const u32x2*)gp; const f32x4 nn = *(const f32x4*)(gnp + EOFF(t) + 8 * g);
            u32x2 pk;
            pk.x = cvt_pk_bf16(acc[t][4 * g] * rs * nn[0] * bf_lo(gw.x), acc[t][4 * g + 1] * rs * nn[1] * bf_hi(gw.x));
            pk.y = cvt_pk_bf16(acc[t][4 * g + 2] * rs * nn[2] * bf_lo(gw.y), acc[t][4 * g + 3] * rs * nn[3] * bf_hi(gw.y));
            *(u32x2*)gp = pk;
        }
#undef EOFF
    __syncthreads();
}
}

#define XB_TMO      128
#define XB_XCNT(j)  (256  + 64 * (j))
#define XB_XSUB(j)  (1280 + 64 * (j))
#define XB_XGEN(j)  (2304 + 64 * (j))
#define XB_TOP      3328
#define XB_TOPGEN   3392
#define XCD_BAR_WORDS 3456
#define XB_SPIN_CAP (1u << 21)
DEVI unsigned xb_ld(unsigned* p)              { return __hip_atomic_load(p, __ATOMIC_RELAXED, __HIP_MEMORY_SCOPE_AGENT); }
DEVI unsigned xb_add(unsigned* p, unsigned v) { return __hip_atomic_fetch_add(p, v, __ATOMIC_RELAXED, __HIP_MEMORY_SCOPE_AGENT); }
DEVI unsigned xb_xcc_id() { return (unsigned)__builtin_amdgcn_s_getreg((3 << 11) | 20) & 0xFu; }
#define XB_SPIN(cond, bar) do { unsigned _sp = 0; while (cond) { __builtin_amdgcn_s_sleep(1); \
    if ((++_sp & 255u) == 0u) { if (xb_ld(&(bar)[XB_TMO])) break; if (_sp > XB_SPIN_CAP) { atomicAdd(&(bar)[XB_TMO], 1u); break; } } } } while (0)
struct XcdBarrier { unsigned* bar; unsigned x; volatile LAS unsigned* st; };
DEVI XcdBarrier xcd_barrier_post(unsigned* bar, volatile LAS unsigned* st) {
    XcdBarrier b; b.bar = bar; b.x = xb_xcc_id(); b.st = st;
    if (threadIdx.x == 0) (void)xb_add(&bar[XB_XCNT(b.x)], 1u);
    return b;
}
DEVI void xcd_barrier_complete(unsigned* bar, unsigned x, unsigned& nloc, unsigned& nx) {
    const unsigned G = gridDim.x * gridDim.y * gridDim.z;
    unsigned sum, cnt, mine, sp = 0u;
    for (;;) {
        sum = 0u; cnt = 0u; mine = 0u;
#pragma unroll
        for (unsigned j = 0; j < 16; ++j) { const unsigned c = xb_ld(&bar[XB_XCNT(j)]); sum += c; cnt += (c > 0u) ? 1u : 0u; mine = (j == x) ? c : mine; }
        if (sum == G) break;
        __builtin_amdgcn_s_sleep(1);
        if ((++sp & 255u) == 0u) { if (xb_ld(&bar[XB_TMO])) break; if (sp > XB_SPIN_CAP) { atomicAdd(&bar[XB_TMO], 1u); break; } }
    }
    nloc = mine > 0u ? mine : 1u; nx = cnt > 0u ? cnt : 1u;
}
DEVI void xcd_barrier(unsigned* bar_, volatile LAS unsigned* st_) {
    asm volatile("s_waitcnt vmcnt(0)" ::: "memory");
    __syncthreads();
    if (threadIdx.x == 0) {
        XcdBarrier b; b.bar = bar_; b.x = xb_xcc_id(); b.st = st_;
        unsigned* bar = b.bar;
        __builtin_amdgcn_s_waitcnt(0);
        unsigned nloc = b.st[0], nx = b.st[1];
        if (nloc == 0u) { xcd_barrier_complete(bar, b.x, nloc, nx); b.st[0] = nloc; b.st[1] = nx; }
        const unsigned old = xb_add(&bar[XB_XSUB(b.x)], 1u);
        const unsigned gen = old / nloc;
        if (old + 1u == (gen + 1u) * nloc) {
            __builtin_amdgcn_fence(__ATOMIC_RELEASE, "agent");
            asm volatile("s_waitcnt vmcnt(0)" ::: "memory");
            const unsigned og = xb_add(&bar[XB_TOP], 1u);
            const unsigned tg = og / nx;
            if (og + 1u == (tg + 1u) * nx) xb_add(&bar[XB_TOPGEN], 1u);
            else XB_SPIN(xb_ld(&bar[XB_TOPGEN]) == tg, bar);
            __builtin_amdgcn_fence(__ATOMIC_ACQUIRE, "agent");
            xb_add(&bar[XB_XGEN(b.x)], 1u);
            asm volatile("s_waitcnt vmcnt(0)" ::: "memory");
        } else {
            XB_SPIN(xb_ld(&bar[XB_XGEN(b.x)]) == gen, bar);
            __builtin_amdgcn_fence(__ATOMIC_ACQUIRE, "agent");
            asm volatile("s_waitcnt vmcnt(0)" ::: "memory");
        }
    }
    __syncthreads();
}

constexpr int NTHR = 512;
constexpr int LDS_XCH = 131072, LDS_MISC = 139264, LDS_RSL = LDS_MISC + 256, LDS_TOTAL = LDS_RSL + 1024 + 16;
static_assert(ret::LDS_SCAN_BYTES <= LDS_MISC, "scan LDS vs control words");
struct Params { const float* in[21]; float* out; unsigned char* ws; int ph_lo, ph_hi; };
enum { I_X = 0, I_C, I_CTX, I_CCTX, I_WADA, I_BADA, I_N1G, I_N2G, I_WIN, I_QNG, I_KNG, I_SINK, I_RLOGIT, I_RNG, I_WPA, I_WPB, I_WPC, I_WO, I_WF1, I_WF2, I_FG };

DEVI int perm_row(int n) {
    const bool p = (n < 1280) || (n >= 1536 && n < 2816);
    if (!p) return n;
    const int t = n & 255, hd = t >> 7, bj = (t >> 6) & 1, dd = t & 63;
    return (n & ~255) + 128 * bj + 64 * hd + dd;
}
DEVI void transpose_item(const float* W, int K, int N, bf16_t* WT, bool perm, LAS float* scr, int item, int lane) {
    const int nblk = N / 32, kb = item / nblk, nb = item % nblk, k0 = 64 * kb, n0 = 32 * nb;
    {
        f32x4 v[8];
        const float* wp = W + (size_t)(k0 + (lane >> 3)) * N + n0 + 4 * (lane & 7);
#pragma unroll
        for (int i = 0; i < 8; ++i) v[i] = *(const f32x4*)(wp + (size_t)(8 * i) * N);
#pragma unroll
        for (int i = 0; i < 8; ++i) { LAS float* d = scr + (8 * i + (lane >> 3)) * 33 + 4 * (lane & 7); d[0] = v[i][0]; d[1] = v[i][1]; d[2] = v[i][2]; d[3] = v[i][3]; }
    }
    asm volatile("s_waitcnt lgkmcnt(0)" ::: "memory");
    const int c = lane & 7;
#pragma unroll
    for (int j = 0; j < 4; ++j) { const int n = (lane >> 3) + 8 * j; const LAS float* s = scr + (8 * c) * 33 + n;
        u32x4 o; o.x = cvt_pk_bf16(s[0 * 33], s[1 * 33]); o.y = cvt_pk_bf16(s[2 * 33], s[3 * 33]); o.z = cvt_pk_bf16(s[4 * 33], s[5 * 33]); o.w = cvt_pk_bf16(s[6 * 33], s[7 * 33]);
        const int nd = perm ? perm_row(n0 + n) : (n0 + n);
        *(u32x4*)(WT + (size_t)nd * K + k0 + 8 * c) = o; }
    asm volatile("s_waitcnt lgkmcnt(0)" ::: "memory");
}
DEVI void convert_weight(const float* W, int K, int N, bf16_t* WT, bool perm, LAS unsigned char* lds, int bid, int nb) {
    const int tid = fresh_tid(); const int wave = tid >> 6, lane = tid & 63;
    LAS float* scr = (LAS float*)(lds + wave * 16384);
    const int items = (K / 64) * (N / 32);
    for (int it = bid * 8 + wave; it < items; it += nb * 8) transpose_item(W, K, N, WT, perm, scr, it, lane);
}
DEVI void dot9_item(const float* W, int ldw, int n0, const float* bvec, float* out, int ldo, LAS float* sL, LAS float* red) {
    const int tid = fresh_tid(); const int wave = tid >> 6, lane = tid & 63;
    float a[9];
#pragma unroll
    for (int r = 0; r < 9; ++r) a[r] = 0.f;
    const float* wp = W + (size_t)(wave * 128) * ldw + n0 + lane;
#pragma unroll 8
    for (int k = 0; k < 128; ++k) { const float wv = wp[(size_t)k * ldw];
#pragma unroll
        for (int r = 0; r < 9; ++r) a[r] += sL[r * 1024 + wave * 128 + k] * wv; }
#pragma unroll
    for (int r = 0; r < 9; ++r) red[(wave * 9 + r) * 64 + lane] = a[r];
    __syncthreads();
    for (int o = tid; o < 9 * 64; o += NTHR) { const int r = o >> 6, c = o & 63; float s = 0.f;
#pragma unroll
        for (int w = 0; w < 8; ++w) s += red[(w * 9 + r) * 64 + c];
        out[(size_t)r * ldo + n0 + c] = s + (bvec ? bvec[n0 + c] : 0.f); }
    __syncthreads();
}
DEVI void sincos_f(float ang, float& c, float& s) {
    const float q = rintf(ang * 0.6366197723675814f);
    float r = fmaf(-q, 1.5703125f, ang); r = fmaf(-q, 4.837512969970703125e-4f, r); r = fmaf(-q, 7.549789948768648e-8f, r);
    const float r2 = r * r;
    const float sp = r + r * r2 * (-1.6666667163e-1f + r2 * (8.3333337680e-3f + r2 * (-1.9841270114e-4f + r2 * 2.7557314297e-6f)));
    const float cp = 1.f + r2 * (-0.5f + r2 * (4.1666667908e-2f + r2 * (-1.3888889225e-3f + r2 * (2.4801587642e-5f + r2 * -2.7557314297e-7f))));
    const int qi = ((int)q) & 3;
    c = (qi == 0) ? cp : (qi == 1) ? -sp : (qi == 2) ? -cp : sp;
    s = (qi == 0) ? sp : (qi == 1) ? cp : (qi == 2) ? -sp : -cp;
}

__global__ void __launch_bounds__(NTHR, 2) mega_fwd(Params P) {
    extern __shared__ __attribute__((aligned(16))) unsigned char lds_raw[];
    cg::grid_group grid = cg::this_grid();
    LAS unsigned char* lds = (LAS unsigned char*)lds_raw;
    const int G = gridDim.x, NGW = G * 8;
#define PHASE_IDS() const int tid = fresh_tid(); const int wave = tid >> 6, lane = tid & 63, gw = blockIdx.x * 8 + wave; (void)lane; (void)gw; (void)wave
    unsigned char* ws = P.ws;
    bf16_t* U = (bf16_t*)(ws + WS_U); float* X = (float*)(ws + WS_X); bf16_t* AP = (bf16_t*)(ws + WS_AP);
    bf16_t* KT = (bf16_t*)(ws + WS_KT); bf16_t* VT = (bf16_t*)(ws + WS_VT);
    bf16_t* Wb = (bf16_t*)(ws + WS_W);
    bf16_t* Win_t = (bf16_t*)(ws + WS_W + W_IN);
    float* MOD = (float*)(ws + WS_MOD); float* B1 = (float*)(ws + WS_B1); float* B2 = (float*)(ws + WS_B2); float* ST = (float*)(ws + WS_ST);
    float* CSH = (float*)(ws + WS_CSH); float* CSR = (float*)(ws + WS_CSR); unsigned* CTR = (unsigned*)(ws + WS_CTR);
    (void)Wb;
    int ph = 0;
    {   volatile LAS unsigned* st0 = (volatile LAS unsigned*)(lds + LDS_MISC + 64); if (threadIdx.x < 2) st0[threadIdx.x] = 0u; if (threadIdx.x == 2) ((volatile LAS int*)(lds + LDS_RSL + 1024))[0] = (int)0xFFFFFFFEu; }
    __syncthreads();
    (void)xcd_barrier_post((unsigned*)(ws + WS_BAR), (volatile LAS unsigned*)(lds + LDS_MISC + 64));
#define GRID_SYNC_CG() do { asm volatile("s_waitcnt vmcnt(0) lgkmcnt(0)" ::: "memory"); grid.sync(); \
        if (threadIdx.x < 64) { __builtin_amdgcn_fence(__ATOMIC_ACQUIRE, "agent"); asm volatile("s_waitcnt vmcnt(0)" ::: "memory"); } __syncthreads(); } while (0)
#define GRID_SYNC_X() xcd_barrier((unsigned*)(P.ws + WS_BAR), (volatile LAS unsigned*)(lds + LDS_MISC + 64))
    if (P.ph_hi < 0) GRID_SYNC_CG();
#define GRID_SYNC(ty) GRID_SYNC_X()
#define PHASE_ON() (P.ph_lo <= ph && ph < P.ph_hi)
#ifdef PROBE_MASK
    unsigned long long t_prev = __builtin_amdgcn_s_memrealtime(), t_sel = 0ull;
#define PHASE_END(ty) do { if (P.ph_lo <= ph && ph + 1 < P.ph_hi) GRID_SYNC(ty); ++ph; \
        { const unsigned long long t_now = __builtin_amdgcn_s_memrealtime(); if ((PROBE_MASK >> (ty)) & 1) t_sel += t_now - t_prev; t_prev = t_now; } } while (0)
#else
#define PHASE_END(ty) do { if (P.ph_lo <= ph && ph + 1 < P.ph_hi) GRID_SYNC(ty); ++ph; } while (0)
#endif

    if (PHASE_ON()) { PHASE_IDS();
        if (blockIdx.x == 0 && tid < 128) CTR[tid] = 0u;
        if (blockIdx.x == 0 && tid < 5 * 72) ((unsigned*)(ws + WS_CNT))[tid * 64] = 0u;
#ifdef DIAG_FILL
        { u32x4* p = (u32x4*)(ws + WS_U); const size_t n16 = (WS_W - WS_U) / 16; const u32x4 z = {0u, 0u, 0u, 0u};
          for (size_t i = (size_t)blockIdx.x * NTHR + tid; i < n16; i += (size_t)G * NTHR) { if (i * 16 >= WS_X && i * 16 < WS_AP) continue; p[i] = z; } }
#endif
        {
            LAS float* sL = (LAS float*)lds; LAS float* red = (LAS float*)(lds + 9 * 1024 * 4);
            for (int i = tid; i < 9 * 1024; i += NTHR) { const float v = (i < 8192) ? P.in[I_C][i] : P.in[I_CCTX][i - 8192]; sL[i] = v * sigmoidf_(v); }
            __syncthreads();
            for (int it = blockIdx.x; it < DEPTH * (NMOD / 64); it += G) { const int l = it / (NMOD / 64), n0 = (it % (NMOD / 64)) * 64;
                dot9_item(P.in[I_WADA] + (size_t)l * DM * NMOD, NMOD, n0, P.in[I_BADA] + (size_t)l * NMOD, MOD + (size_t)l * 9 * NMOD, NMOD, sL, red); }
            __syncthreads();
        }
        bf16_t* Wpa_t = (bf16_t*)(ws + WS_W + W_PA); bf16_t* Wpb_t = (bf16_t*)(ws + WS_W + W_PB); bf16_t* Wpc_t = (bf16_t*)(ws + WS_W + W_PC);
        bf16_t* Wo_t = (bf16_t*)(ws + WS_W + W_O); bf16_t* Wf1_t = (bf16_t*)(ws + WS_W + W_F1); bf16_t* Wf2_t = (bf16_t*)(ws + WS_W + W_F2);
        convert_weight(P.in[I_WIN], DM, NIN, Win_t, true, lds, (int)blockIdx.x, G);
        convert_weight(P.in[I_WPA], DM, DM, Wpa_t, false, lds, (int)blockIdx.x, G);
        convert_weight(P.in[I_WPB], DM, DM, Wpb_t, false, lds, (int)blockIdx.x, G);
        convert_weight(P.in[I_WPC], 2048, DM, Wpc_t, false, lds, (int)blockIdx.x, G);
        convert_weight(P.in[I_WO], DM, DM, Wo_t, false, lds, (int)blockIdx.x, G);
        convert_weight(P.in[I_WF1], DM, DFF, Wf1_t, false, lds, (int)blockIdx.x, G);
        convert_weight(P.in[I_WF2], DFF, DM, Wf2_t, false, lds, (int)blockIdx.x, G);
        for (int i = blockIdx.x * NTHR + tid; i < SEQ * 64; i += G * NTHR) { const int pos = i >> 6, dd = i & 63, j = dd & 31, p = dd < 32 ? (pos >> 6) : (pos & 63);
            const float inv = fexp2(-(float)j * (13.287712379549449f / 32.f)); float c, s; sincos_f((float)p * inv, c, s); CSH[2 * i] = c; CSH[2 * i + 1] = s; }
        for (int i = blockIdx.x * NTHR + tid; i < SEQ * 128; i += G * NTHR) { const int pos = i >> 7, dd = i & 127, j = dd & 63, p = dd < 64 ? (pos >> 6) : (pos & 63);
            const float inv = fexp2(-(float)j * (13.287712379549449f / 64.f)); float c, s; sincos_f((float)p * inv, c, s); CSR[2 * i] = c; CSR[2 * i + 1] = s; }
        __syncthreads();
    }
    PHASE_END(0);

    if (PHASE_ON()) { PHASE_IDS();
        LAS float* sL = (LAS float*)lds; LAS float* red = (LAS float*)(lds + 9 * 1024 * 4);
        constexpr int IT1 = NIN / 64, IT2 = DFF / 64;
        for (int it = blockIdx.x; it < DEPTH * (IT1 + IT2); it += G) {
            const int l = it / (IT1 + IT2), r = it % (IT1 + IT2); const bool first = r < IT1;
            const float* md = MOD + (size_t)l * 9 * NMOD + (first ? 0 : 3 * DM);
            for (int i = tid; i < 9 * 1024; i += NTHR) sL[i] = md[(size_t)(i >> 10) * NMOD + (i & 1023)];
            __syncthreads();
            if (first) dot9_item(P.in[I_WIN] + (size_t)l * DM * NIN, NIN, r * 64, nullptr, B1 + (size_t)l * 9 * NIN, NIN, sL, red);
            else dot9_item(P.in[I_WF1] + (size_t)l * DM * DFF, DFF, (r - IT1) * 64, nullptr, B2 + (size_t)l * 9 * DFF, DFF, sL, red);
        }
        for (int row = gw; row < M_ALL; row += NGW) {
            const bool lat = row < M_LAT; const int rmod = lat ? (row >> 11) : 8;
            const float* src = lat ? P.in[I_X] + (size_t)row * DM : P.in[I_CTX] + (size_t)(row - M_LAT) * DM;
            const float* scp = MOD + (size_t)rmod * NMOD + DM; const float* ng = P.in[I_N1G];
            float ss = 0.f;
#pragma unroll
            for (int j = 0; j < 4; ++j) { const int c = 4 * lane + 256 * j; const f32x4 v = *(const f32x4*)(src + c);
                *(f32x4*)(X + (size_t)row * DM + c) = v; ss += (v[0] * v[0] + v[1] * v[1]) + (v[2] * v[2] + v[3] * v[3]);
                const f32x4 g = *(const f32x4*)(ng + c), s = *(const f32x4*)(scp + c); const f32x4 a = v * (g * (s + 1.0f));
                u32x2 pk; pk.x = cvt_pk_bf16(a[0], a[1]); pk.y = cvt_pk_bf16(a[2], a[3]); *(u32x2*)(AP + (size_t)row * DM + c) = pk; }
            ss = wave_sum(ss);
            if (lane < 16) ST[(size_t)row * 16 + lane] = lane == 0 ? ss : 0.f;
        }
    }
    PHASE_END(1);

    for (int l = 0; l < DEPTH; ++l) {
        const bool need_ctx = l < DEPTH - 1;
        const float* MODl = MOD + (size_t)l * 9 * NMOD;
        const int M2 = need_ctx ? M_ALL : M_LAT;
        const size_t wsm = (l & 1) ? W_SM : 0;
        bf16_t* Wpa_t = (bf16_t*)(ws + WS_W + W_PA + wsm); bf16_t* Wpb_t = (bf16_t*)(ws + WS_W + W_PB + wsm); bf16_t* Wpc_t = (bf16_t*)(ws + WS_W + W_PC + wsm);
        bf16_t* Wo_t = (bf16_t*)(ws + WS_W + W_O + wsm); bf16_t* Wf1_t = (bf16_t*)(ws + WS_W + W_F1 + wsm); bf16_t* Wf2_t = (bf16_t*)(ws + WS_W + W_F2 + wsm);
        if (PHASE_ON()) { PHASE_IDS();
            pg8::Gemm g{AP, DM, Win_t, DM}; pg8::StaticOrder S; S.init(M_ALL, NIN, G, (int)blockIdx.x);
            if (l > 0) { S.ready = (const unsigned*)(ws + WS_CNT) + 3 * 72 * 64; S.need = 4u * (unsigned)l; }
            if (l == DEPTH - 1) { S.init(M_LAT, NIN, G, (int)blockIdx.x); S.ready = (const unsigned*)(ws + WS_CNT) + 3 * 72 * 64; S.need = 4u * (unsigned)l; S.nextra = 128; }
            pg8::EpiIn E{U, ST, B1 + (size_t)l * 9 * NIN, P.in[I_QNG] + l * 128, P.in[I_KNG] + l * 128, CSH, CSR, KT, VT, P.in[I_RLOGIT] + l * 8, (LAS float*)(lds + LDS_XCH), (LAS float*)(lds + LDS_RSL)};
            pg8::gemm_phase(lds, g, S, E);
        }
        PHASE_END(2);
        if (PHASE_ON()) { PHASE_IDS();
#ifdef PROBE_MASK
            const unsigned long long tc0 = __builtin_amdgcn_s_memrealtime();
#endif
#ifdef PROBE_MASK
            if ((PROBE_MASK >> 10) & 1) t_sel += __builtin_amdgcn_s_memrealtime() - tc0;
#endif
            LAS int* misc = (LAS int*)(lds + LDS_MISC);
            const int nq = (G % 8 == 0) ? 8 : 1, qx = (int)blockIdx.x % nq, qslot = (int)blockIdx.x / nq, qn = G / nq;
            for (int sl = qslot; sl < 256 / nq; sl += qn) {
                const int pair = nq == 8 ? 4 * qx + (sl >> 3) : (sl >> 3), es = sl & 7, b = pair >> 2, h = pair & 3;
                const float lgf = log2_sigmoid(P.in[I_RLOGIT][l * 8 + h]), lgb = log2_sigmoid(P.in[I_RLOGIT][l * 8 + 4 + h]);
                ret::scan_unit(b, h, es, U, KT, VT, lgf, lgb, (char*)lds_raw, (unsigned*)(ws + WS_CNT) + (4 * 72 + b * 4 + h) * 64);
            }
            const int per_b = 128 + (need_ctx ? 16 : 0), nb_q = NB / nq, qtotal = per_b * nb_q;
            for (;;) {
                if (tid == 0) misc[0] = (int)atomicAdd(&CTR[l * 16 + qx], 1u);
                __syncthreads();
                const int ui = misc[0];
                __syncthreads();
                if (ui >= qtotal) break;
                {
                    att::AUnit a; const int b = (nq == 8) ? qx : ui / per_b; int i = ui % per_b;
                    if (i < 64) {
                        const int h = i >> 3, qb = i & 7, kv = h >> 2; const size_t qrow = (size_t)b * SEQ + qb * 256;
                        a.Q = U + qrow * LDU + AQ + h * 128; a.O = U + qrow * LDU + AQ + h * 128; a.K = U + AK + kv * 128; a.V = U + AV + kv * 128;
                        a.base1 = b * SEQ; a.n1 = 32; a.base2 = M_LAT + b * CTX; a.NT = 36; a.mask = 0; a.q0pos = 0; a.k0pos = 0; a.m0 = -1e30f; a.l0 = 0.f;
                    } else if (i < 128) {
                        i -= 64; const int h = i >> 3, qb = i & 7, kv = h >> 2; const size_t qrow = (size_t)b * SEQ + qb * 256;
                        const int ks = qb == 0 ? 0 : qb * 256 - 128, ke = qb == 7 ? SEQ : qb * 256 + 384;
                        a.Q = U + qrow * LDU + BQ + h * 128; a.O = U + qrow * LDU + BQ + h * 128; a.K = U + BKO + kv * 128; a.V = U + BV + kv * 128;
                        a.base1 = b * SEQ + ks; a.n1 = (ke - ks) / 64; a.base2 = M_LAT + b * CTX; a.NT = a.n1 + 4; a.mask = 1; a.q0pos = qb * 256; a.k0pos = ks;
                        a.m0 = P.in[I_SINK][l * 8 + h] * (1.f / att::SCALE); a.l0 = 1.f;
                    } else {
                        i -= 128; const int isb = i >> 3, h = i & 7, kv = h >> 2; const size_t qrow = (size_t)M_LAT + b * CTX;
                        const int qo = isb ? BQ : AQ, ko = isb ? BKO : AK, vo = isb ? BV : AV;
                        a.Q = U + qrow * LDU + qo + h * 128; a.O = U + qrow * LDU + qo + h * 128; a.K = U + ko + kv * 128; a.V = U + vo + kv * 128;
                        a.base1 = 0; a.n1 = 0; a.base2 = M_LAT + b * CTX; a.NT = 4; a.mask = 0; a.q0pos = 0; a.k0pos = 0;
                        a.m0 = isb ? P.in[I_SINK][l * 8 + h] * (1.f / att::SCALE) : -1e30f; a.l0 = isb ? 1.f : 0.f;
                    }
                    att::attn_unit(a, (char*)lds_raw);
                }
            }
        }
        ++ph;
        if (PHASE_ON()) { PHASE_IDS();
            const float* gn = P.in[I_RNG] + (size_t)l * 2048;
            const int nch = need_ctx ? 18 : 16, total = NB * 4 * nch;
            const int nconv = (l + 1 < DEPTH) ? 400 : 0;
            LAS int* misc = (LAS int*)(lds + LDS_MISC);
            for (;;) {
                if (tid == 0) misc[0] = (int)atomicAdd(&CTR[96 + l], 1u);
                __syncthreads();
                const int u = misc[0];
                __syncthreads();
                if (u >= total + nconv) break;
                if (u < total) {
                    const int bh = u / nch, ci = u % nch + (need_ctx ? 0 : 2), b = bh >> 2, h = bh & 3;
                    const float lgf = log2_sigmoid(P.in[I_RLOGIT][l * 8 + h]), lgb = log2_sigmoid(P.in[I_RLOGIT][l * 8 + 4 + h]);
                    {
                        if (tid < 64) { const unsigned* rc = (const unsigned*)(ws + WS_CNT) + (4 * 72 + b * 4 + h) * 64;
                            while ((unsigned)__builtin_amdgcn_readfirstlane(__hip_atomic_load(rc, __ATOMIC_RELAXED, __HIP_MEMORY_SCOPE_AGENT)) < 8u * (unsigned)(l + 1)) {
                                __builtin_amdgcn_s_sleep(2); }
                            __builtin_amdgcn_fence(__ATOMIC_ACQUIRE, "agent"); asm volatile("s_waitcnt vmcnt(0)" ::: "memory"); }
                        __syncthreads();
                    }
                    ret::intra_unit(b, h, ci, U, VT, gn, lgf, lgb, (char*)lds_raw);
                } else {
                    const size_t wsn = ((l + 1) & 1) ? W_SM : 0;
                    LAS float* scr = (LAS float*)(lds + wave * 16384);
#pragma unroll 1
                    for (int j = 0; j < 4; ++j) {
                        int g = (u - total) * 32 + wave * 4 + j;
                        if (g < 6144) { transpose_item(P.in[I_WIN] + (size_t)(l + 1) * DM * NIN, DM, NIN, Win_t, true, scr, g, lane); continue; } g -= 6144;
                        if (g < 512) { transpose_item(P.in[I_WPA] + (size_t)(l + 1) * DM * DM, DM, DM, (bf16_t*)(ws + WS_W + W_PA + wsn), false, scr, g, lane); continue; } g -= 512;
                        if (g < 512) { transpose_item(P.in[I_WPB] + (size_t)(l + 1) * DM * DM, DM, DM, (bf16_t*)(ws + WS_W + W_PB + wsn), false, scr, g, lane); continue; } g -= 512;
                        if (g < 1024) { transpose_item(P.in[I_WPC] + (size_t)(l + 1) * 2048 * DM, 2048, DM, (bf16_t*)(ws + WS_W + W_PC + wsn), false, scr, g, lane); continue; } g -= 1024;
                        if (g < 512) { transpose_item(P.in[I_WO] + (size_t)(l + 1) * DM * DM, DM, DM, (bf16_t*)(ws + WS_W + W_O + wsn), false, scr, g, lane); continue; } g -= 512;
                        if (g < 2048) { transpose_item(P.in[I_WF1] + (size_t)(l + 1) * DM * DFF, DM, DFF, (bf16_t*)(ws + WS_W + W_F1 + wsn), false, scr, g, lane); continue; } g -= 2048;
                        if (g < 2048) transpose_item(P.in[I_WF2] + (size_t)(l + 1) * DFF * DM, DFF, DM, (bf16_t*)(ws + WS_W + W_F2 + wsn), false, scr, g, lane);
                    }
                }
            }
        }
        PHASE_END(4);
        if (PHASE_ON()) { PHASE_IDS();
            unsigned* cntY = (unsigned*)(ws + WS_CNT); unsigned* cntX = cntY + 72 * 64; unsigned* cntH = cntX + 72 * 64;
            const int c = (int)blockIdx.x;
            const unsigned ep = (unsigned)(l + 1);
            {
                pg8::ChainOrder S; S.init(4, G, c, need_ctx ? 32 : 0, 0, nullptr, 0u, nullptr);
                { pg8::Gemm g{U + AQ, LDU, Wpa_t, DM}; pg8::EpiMerge1<0> E{U, GA}; pg8::gemm_phase(lds, g, S, E); }
                { pg8::Gemm g{U + BQ, LDU, Wpb_t, DM}; pg8::EpiMerge1<1> E{U, GB}; pg8::gemm_phase(lds, g, S, E); }
                S.pub = cntY;
                { pg8::Gemm g{U + CG, LDU, Wpc_t, 2048}; pg8::EpiMerge1<1> E{U, GC}; pg8::gemm_phase(lds, g, S, E); }
            }
            {
                pg8::ChainOrder S; S.init(4, G, c, need_ctx ? 32 : 0, 64, cntY, 4u * ep, cntX);
                pg8::Gemm g{U + YOFF, LDU, Wo_t, DM};
                pg8::EpiRes E{X, X, MODl + 2 * DM, P.in[I_N2G] + (size_t)l * DM, MODl + 4 * DM, AP, ST};
                pg8::gemm_phase(lds, g, S, E);
            }
            {
                pg8::ChainOrder S; S.init(16, G, c, need_ctx ? 128 : 0, 0, cntX, 4u * ep, cntH);
                pg8::Gemm g{AP, DM, Wf1_t, DM};
                pg8::EpiFfn1 E{U, ST, B2 + (size_t)l * 9 * DFF, (LAS float*)(lds + LDS_RSL)};
                pg8::gemm_phase(lds, g, S, E);
            }
            {
                pg8::ChainOrder S; S.init(4, G, c, need_ctx ? 32 : 0, 224, cntH, 16u * ep, need_ctx ? cntH + 72 * 64 : nullptr);
                pg8::Gemm g{U, LDU, Wf2_t, DFF};
                const float* MODn = MOD + (size_t)(l + 1) * 9 * NMOD;
                pg8::EpiRes E{X, need_ctx ? X : P.out, MODl + 5 * DM, need_ctx ? P.in[I_N1G] + (size_t)(l + 1) * DM : nullptr, need_ctx ? MODn + DM : nullptr, AP, ST};
                pg8::gemm_phase(lds, g, S, E);
            }
        }
        if (need_ctx) { ++ph; } else { PHASE_END(5); }
    }
    if (PHASE_ON()) { PHASE_IDS();
        const float* fg = P.in[I_FG];
        for (int row = gw; row < M_LAT; row += NGW) {
            const float rs = pg8::row_rstd(ST, row);
#pragma unroll
            for (int j = 0; j < 4; ++j) { const int c = 4 * lane + 256 * j; float* p = P.out + (size_t)row * DM + c;
                const f32x4 v = *(const f32x4*)p, g = *(const f32x4*)(fg + c); *(f32x4*)p = v * rs * g; }
        }
    }
#ifdef PROBE_MASK
    if (blockIdx.x == 0) { const unsigned long long t0 = __builtin_amdgcn_s_memrealtime(); while (__builtin_amdgcn_s_memrealtime() - t0 < t_sel) __builtin_amdgcn_s_sleep(32); }
#endif
}
constexpr int N_PHASES = 2 + 4 * DEPTH + 1;

extern "C" void kernel_launch(void* const* d_in, const int* in_sizes, int n_in, void* d_out, int out_size, void* d_ws, size_t ws_size, hipStream_t stream) {
    static int grid = 0;
    if (grid == 0) {
        if (n_in != 21 || out_size != M_LAT * DM || ws_size < WS_END) { fprintf(stderr, "kernel_launch: unexpected shapes (n_in %d out %d ws %zu need %zu)\n", n_in, out_size, ws_size, (size_t)WS_END); grid = -1; return; }
        int dev = 0, cus = 0, per_cu = 0;
        hipGetDevice(&dev); hipDeviceGetAttribute(&cus, hipDeviceAttributeMultiprocessorCount, dev);
        if (hipFuncSetAttribute((const void*)mega_fwd, hipFuncAttributeMaxDynamicSharedMemorySize, LDS_TOTAL) != hipSuccess) { fprintf(stderr, "kernel_launch: LDS attribute failed\n"); grid = -1; return; }
        hipOccupancyMaxActiveBlocksPerMultiprocessor(&per_cu, (const void*)mega_fwd, NTHR, LDS_TOTAL);
        if (per_cu < 1) { fprintf(stderr, "kernel_launch: occupancy query says %d\n", per_cu); per_cu = 1; }
        (void)hipGetLastError();
        grid = cus;
    }
    if (grid < 0) return;
    if (hipMemsetAsync((char*)d_ws + WS_BAR, 0, 16384, stream) != hipSuccess) { fprintf(stderr, "kernel_launch: memset of the barrier words failed\n"); return; }
    Params p{};
    for (int i = 0; i < 21; ++i) p.in[i] = (const float*)d_in[i];
    p.out = (float*)d_out; p.ws = (unsigned char*)d_ws; p.ph_lo = 0; p.ph_hi = N_PHASES;
    void* args[] = {&p};
    hipError_t e = hipLaunchCooperativeKernel((const void*)mega_fwd, dim3(grid), dim3(NTHR), args, LDS_TOTAL, stream);
    if (e != hipSuccess) fprintf(stderr, "cooperative launch failed: %s (grid %d)\n", hipGetErrorString(e), grid);
}
```

```cpp
#include <hip/hip_runtime.h>
#include <hip/hip_cooperative_groups.h>
#include <cstdio>
#include <cstdint>
namespace cg = cooperative_groups;

#define DEVI __device__ __forceinline__
#define LAS __attribute__((address_space(3)))
typedef unsigned short bf16_t;
typedef short bf16x8 __attribute__((ext_vector_type(8)));
typedef short s16x4 __attribute__((ext_vector_type(4)));
typedef float f32x4 __attribute__((ext_vector_type(4)));
typedef float f32x16 __attribute__((ext_vector_type(16)));
typedef unsigned u32x4 __attribute__((ext_vector_type(4)));
typedef unsigned u32x2 __attribute__((ext_vector_type(2)));

constexpr int DM = 1024, NB = 8, SEQ = 2048, DEPTH = 4, CTX = 256;
constexpr int M_LAT = NB * SEQ, M_CTX = NB * CTX, M_ALL = M_LAT + M_CTX;
constexpr int NIN = 12288, DFF = 4096, NMOD = 6 * DM;
constexpr int LDU = NIN;
constexpr int AQ = 0, AK = 1024, AV = 1280, BQ = 1536, BKO = 2560, BV = 2816, CQ = 3072, CK = 4096, CV = 5120, CG = 7168, GA = 9216, GB = 10240, GC = 11264;
constexpr int YOFF = CQ;
constexpr int TAU = SEQ + CTX;
constexpr float EPS = 1e-6f;
constexpr size_t WS_U = 0;
constexpr size_t WS_X = WS_U + (size_t)M_ALL * NIN * 2;
constexpr size_t WS_AP = WS_X + (size_t)M_ALL * DM * 4;
constexpr size_t WS_KT = WS_AP + (size_t)M_ALL * DM * 2;
constexpr size_t WS_VT = WS_KT + (size_t)2 * NB * 4 * 256 * TAU * 2;
constexpr size_t WS_W = WS_VT + (size_t)NB * 4 * 512 * TAU * 2;
constexpr size_t W_IN = 0, W_PA = W_IN + (size_t)NIN * DM * 2, W_PB = W_PA + (size_t)DM * DM * 2, W_PC = W_PB + (size_t)DM * DM * 2,
                 W_O = W_PC + (size_t)DM * 2048 * 2, W_F1 = W_O + (size_t)DM * DM * 2, W_F2 = W_F1 + (size_t)DFF * DM * 2, W_END = W_F2 + (size_t)DM * DFF * 2;
constexpr size_t W_SM = W_END - W_PA;
constexpr size_t WS_MOD = WS_W + W_END + W_SM;
constexpr size_t WS_B1 = WS_MOD + (size_t)DEPTH * 9 * NMOD * 4;
constexpr size_t WS_B2 = WS_B1 + (size_t)DEPTH * 9 * NIN * 4;
constexpr size_t WS_ST = WS_B2 + (size_t)DEPTH * 9 * DFF * 4;
constexpr size_t WS_CSH = WS_ST + (size_t)M_ALL * 16 * 4;
constexpr size_t WS_CSR = WS_CSH + (size_t)SEQ * 64 * 8;
constexpr size_t WS_CTR = WS_CSR + (size_t)SEQ * 128 * 8;
constexpr size_t WS_CNT = WS_CTR + 4096;
constexpr size_t WS_BAR = WS_CNT + 5 * 72 * 256;
constexpr size_t WS_END = WS_BAR + 16384;
static_assert(WS_END <= 805306368ull, "workspace");

DEVI unsigned cvt_pk_bf16(float lo, float hi) { unsigned r; asm volatile("v_cvt_pk_bf16_f32 %0, %1, %2" : "=v"(r) : "v"(lo), "v"(hi)); return r; }
typedef float f32x2_t __attribute__((ext_vector_type(2))); typedef __bf16 bf16x2_t __attribute__((ext_vector_type(2)));
DEVI unsigned cvt_pk_bf16_c(float lo, float hi) { const f32x2_t v = {lo, hi}; const bf16x2_t b = __builtin_convertvector(v, bf16x2_t); return __builtin_bit_cast(unsigned, b); }
DEVI float bf_lo(unsigned w) { return __uint_as_float(w << 16); }
DEVI float bf_hi(unsigned w) { return __uint_as_float(w & 0xffff0000u); }
DEVI bf16_t f2bf(float f) { return (bf16_t)(cvt_pk_bf16(f, 0.f) & 0xffffu); }
DEVI float bf2f(bf16_t b) { return __uint_as_float((unsigned)b << 16); }
DEVI float wave_sum(float v) {
#pragma unroll
    for (int o = 1; o < 64; o <<= 1) v += __shfl_xor(v, o);
    return v;
}
DEVI float sigmoidf_(float x) { return __builtin_amdgcn_rcpf(1.f + __builtin_amdgcn_exp2f(-1.4426950408889634f * x)); }
DEVI float log2_sigmoid(float x) { return -log1pf(__expf(-x)) * 1.4426950408889634f; }
DEVI float fexp2(float x) { return __builtin_amdgcn_exp2f(x); }
DEVI int fresh_tid() { int t = threadIdx.x; asm volatile("" : "+v"(t)); return t; }
DEVI int crow(int r, int hi) { return (r & 3) + 8 * (r >> 2) + 4 * hi; }
#define MFMA32(a, b, c) __builtin_amdgcn_mfma_f32_32x32x16_bf16((a), (b), (c), 0, 0, 0)

namespace pg8 {
constexpr int BM = 256, BK = 64, HALF = 128, HTB = HALF * BK * 2, STAGE_BYTES = 8 * HTB, NXCD = 8, WGM = 8;
__host__ __device__ __forceinline__ int lds_byte(int r, int c) { const int st = (r >> 4) * 2 + (c >> 5), rr = r & 15, cc = c & 31, ob = rr * 64 + cc * 2; return st * 1024 + (ob ^ (((ob >> 9) & 1) << 5)); }
__host__ __device__ __forceinline__ void stage_rc(int b, int& R, int& C) { const int st = b / 1024, sb = b % 1024, swz = sb ^ (((sb >> 9) & 1) << 5); R = (st >> 1) * 16 + swz / 64; C = (st & 1) * 32 + (swz % 64) / 2; }
__host__ __device__ __forceinline__ int perm32(int rho) { const int n = rho >> 4, i = rho & 15; return 8 * (i >> 2) + 4 * n + (i & 3); }
struct Unit { int pm, pn; };
struct Gemm { const bf16_t* A; int lda; const bf16_t* Bt; int K; };
struct StaticOrder {
    int nM, nN, nwg, G, c; const unsigned* ready; unsigned need;
    int nextra;
    __device__ void init(int M, int N, int G_, int c_) { nM = M / BM; nN = N / BM; nwg = nM * nN; G = G_; c = c_; ready = nullptr; need = 0u; nextra = 0; }
    __device__ bool next(int i, Unit& u) const {
        const long L = (long)i * G + c;
        if (L >= nwg) { const int j = (int)(L - nwg); if (j >= nextra) return false;
            const int k = j >> 3; u.pm = 64 + (j & 7); u.pn = k < 2 ? 4 + k : (k < 4 ? 8 + k : 12 + k); return true; }
        int wgid = (int)L; { const int q = nwg / NXCD, r = nwg % NXCD, xcd = wgid % NXCD, off = wgid / NXCD; wgid = (xcd < r ? xcd * (q + 1) : r * (q + 1) + (xcd - r) * q) + off; }
        const int nig = WGM * nN, gid = wgid / nig, fm = gid * WGM, gsz = (nM - fm) < WGM ? (nM - fm) : WGM;
        u.pm = fm + ((wgid % nig) % gsz); u.pn = (wgid % nig) / gsz; return true;
    }
    __device__ __forceinline__ void a_ready(const Unit& u) const {
        if (ready) {
            if (threadIdx.x < 64) {

                while ((unsigned)__builtin_amdgcn_readfirstlane(__hip_atomic_load(ready + 64 * u.pm, __ATOMIC_RELAXED, __HIP_MEMORY_SCOPE_AGENT)) < need) {
                    __builtin_amdgcn_s_sleep(2); }
                __builtin_amdgcn_fence(__ATOMIC_ACQUIRE, "agent");
                asm volatile("s_waitcnt vmcnt(0)" ::: "memory");
            }
            asm volatile("" ::: "memory"); __builtin_amdgcn_s_barrier(); asm volatile("" ::: "memory");
        }
    }
    __device__ __forceinline__ void done(const Unit&) const {}
};
struct ChainOrder {
    int nN, nLat, G, c, nctx, c0, nl; const unsigned* ready; unsigned need; unsigned* pub;
    __device__ void init(int nN_, int G_, int c_, int nctx_, int c0_, const unsigned* ready_, unsigned need_, unsigned* pub_) {
        nN = nN_; nLat = 64 * nN_; G = G_; c = c_; nctx = nctx_; c0 = c0_; ready = ready_; need = need_; pub = pub_; nl = c_ < nLat ? (nLat - c_ + G_ - 1) / G_ : 0; }
    __device__ bool next(int i, Unit& u) const {
        if (i < nl) {
            int wgid = i * G + c; { const int q = nLat / NXCD, xcd = wgid % NXCD, off = wgid / NXCD; wgid = xcd * q + off; }
            const int nig = WGM * nN; u.pm = (wgid / nig) * WGM + (wgid % nig) % WGM; u.pn = (wgid % nig) / WGM; return true;
        }
        if (i == nl && c >= c0 && c < c0 + nctx) { const int j = c - c0; u.pm = 64 + (j & 7); u.pn = j >> 3; return true; }
        return false;
    }
    __device__ __forceinline__ void a_ready(const Unit& u) const {
        if (ready) {
            if (threadIdx.x < 64) {

                while ((unsigned)__builtin_amdgcn_readfirstlane(__hip_atomic_load(ready + 64 * u.pm, __ATOMIC_RELAXED, __HIP_MEMORY_SCOPE_AGENT)) < need) {
                    __builtin_amdgcn_s_sleep(2); }
                __builtin_amdgcn_fence(__ATOMIC_ACQUIRE, "agent");
                asm volatile("s_waitcnt vmcnt(0)" ::: "memory");
            }
            asm volatile("" ::: "memory"); __builtin_amdgcn_s_barrier(); asm volatile("" ::: "memory");
        }
    }
    __device__ __forceinline__ void done(const Unit& u) const {
        if (pub) {
            asm volatile("s_waitcnt vmcnt(0)" ::: "memory"); __builtin_amdgcn_s_barrier(); asm volatile("" ::: "memory");
            if (threadIdx.x < 64) {
                __builtin_amdgcn_fence(__ATOMIC_RELEASE, "agent"); asm volatile("s_waitcnt vmcnt(0)" ::: "memory");
                if (threadIdx.x == 0) __hip_atomic_fetch_add(pub + 64 * u.pm, 1u, __ATOMIC_RELAXED, __HIP_MEMORY_SCOPE_AGENT);
            }
        }
    }
};
template <class Epi, class Sched>
__device__ __forceinline__ void gemm_phase(LAS unsigned char* lds, const Gemm g, const Sched& S, const Epi& E) {
    const int tid = fresh_tid();
    const int wid = __builtin_amdgcn_readfirstlane(tid >> 6), lane = tid & 63, wr = wid >> 2, wc = wid & 3, fr = lane & 15, fq = lane >> 4;
    const int K = g.K, nt = K / BK, lda = g.lda;
    unsigned voffA[2], voffB[2];
#pragma unroll
    for (int i = 0; i < 2; ++i) { int R, C; stage_rc(tid * 16 + i * 8192, R, C); const int Rb = (R & ~31) + perm32(R & 31);
        voffA[i] = (unsigned)(R * lda + C) * 2u; voffB[i] = (unsigned)(Rb * K + C) * 2u; }
    const size_t kstep = (size_t)(BK * 2);
    const size_t hstepA = (size_t)HALF * lda * 2, hstepB = (size_t)HALF * K * 2;
    const size_t tstepA = 2 * hstepA, tstepB = 2 * hstepB;
    const unsigned ldsw = (unsigned)wid * 1024u;
    const int aoff = lds_byte(wr * 64 + fr, fq * 8), boff = lds_byte(wc * 32 + fr, fq * 8);
#define PG8_SA(b, h) (((b) * 2 + (h)) * HTB)
#define PG8_SB(b, h) ((4 + (b) * 2 + (h)) * HTB)
#define PG8_STAGE(bufoff, gbase, voff) do { _Pragma("unroll") for (int _i = 0; _i < 2; ++_i) \
        __builtin_amdgcn_global_load_lds((const unsigned*)((const char*)(gbase) + (voff)[_i]), (LAS unsigned*)(lds + (bufoff) + ldsw + _i * 8192), 16, 0, 0); } while (0)
#define PG8_LDA(dst, b, h) do { _Pragma("unroll") for (int m = 0; m < 4; ++m) _Pragma("unroll") for (int k = 0; k < 2; ++k) dst[m][k] = *(const LAS bf16x8*)(lds + PG8_SA(b, h) + aoff + m * 2048 + k * 1024); } while (0)
#define PG8_LDB(dst, b, h) do { _Pragma("unroll") for (int n = 0; n < 2; ++n) _Pragma("unroll") for (int k = 0; k < 2; ++k) dst[n][k] = *(const LAS bf16x8*)(lds + PG8_SB(b, h) + boff + n * 2048 + k * 1024); } while (0)
#define PG8_MMA(ai, bj, At, Bt) do { __builtin_amdgcn_s_setprio(1); _Pragma("unroll") for (int m = 0; m < 4; ++m) _Pragma("unroll") for (int n = 0; n < 2; ++n) _Pragma("unroll") for (int k = 0; k < 2; ++k) \
        acc[ai][bj][m][n] = __builtin_amdgcn_mfma_f32_16x16x32_bf16(Bt[n][k], At[m][k], acc[ai][bj][m][n], 0, 0, 0); __builtin_amdgcn_s_setprio(0); } while (0)
#define PG8_WAIT_V(n) asm volatile("s_waitcnt vmcnt(" #n ")" ::: "memory")
#define PG8_WAIT_L(n) asm volatile("s_waitcnt lgkmcnt(" #n ")" ::: "memory")
#define PG8_BAR __builtin_amdgcn_s_barrier()
#define PG8_SCHED __builtin_amdgcn_sched_barrier(0)
    Unit cur, nxt; int ui = 0;
    if (!S.next(0, cur)) return;
    f32x4 acc[2][2][4][2];
#pragma unroll
    for (int a = 0; a < 2; ++a)
#pragma unroll
        for (int b = 0; b < 2; ++b)
#pragma unroll
            for (int m = 0; m < 4; ++m)
#pragma unroll
                for (int n = 0; n < 2; ++n) acc[a][b][m][n] = (f32x4){0.f, 0.f, 0.f, 0.f};
    bf16x8 At[4][2], B0[2][2], B1[2][2];
    const char* cA = (const char*)g.A + (size_t)cur.pm * tstepA; const char* cB = (const char*)g.Bt + (size_t)cur.pn * tstepB;
    S.a_ready(cur);
    PG8_STAGE(PG8_SB(0, 0), cB, voffB); PG8_STAGE(PG8_SB(0, 1), cB + hstepB, voffB); PG8_STAGE(PG8_SA(0, 0), cA, voffA); PG8_STAGE(PG8_SA(0, 1), cA + hstepA, voffA);
    if (wr == 1) PG8_BAR;
    PG8_WAIT_V(2); PG8_BAR;
    PG8_STAGE(PG8_SB(1, 0), cB + kstep, voffB); PG8_STAGE(PG8_SA(1, 0), cA + kstep, voffA); PG8_STAGE(PG8_SB(1, 1), cB + hstepB + kstep, voffB);
    PG8_WAIT_V(6); PG8_BAR;
    for (;;) {
        const bool has_next = S.next(ui + 1, nxt);
        const char* nA = has_next ? (const char*)g.A + (size_t)nxt.pm * tstepA : cA; const char* nB = has_next ? (const char*)g.Bt + (size_t)nxt.pn * tstepB : cB;
        for (int t = 0; t < nt; t += 2) {
            const bool last = (t == nt - 2);
            const char* a1 = cA + (size_t)(t + 1) * kstep;
            const char* a2 = last ? nA : cA + (size_t)(t + 2) * kstep; const char* b2 = last ? nB : cB + (size_t)(t + 2) * kstep;
            const char* a3 = a2 + kstep; const char* b3 = b2 + kstep;
            if (last && has_next) S.a_ready(nxt);
            PG8_LDB(B0, 0, 0); PG8_LDB(B1, 0, 1); PG8_SCHED; PG8_LDA(At, 0, 0); PG8_STAGE(PG8_SA(1, 1), a1 + hstepA, voffA);
            PG8_WAIT_V(8); PG8_WAIT_L(0); PG8_BAR; PG8_MMA(0, 0, At, B0); PG8_MMA(0, 1, At, B1); PG8_BAR; PG8_SCHED;
            PG8_LDA(At, 0, 1); PG8_STAGE(PG8_SB(0, 0), b2, voffB); PG8_STAGE(PG8_SB(0, 1), b2 + hstepB, voffB); PG8_STAGE(PG8_SA(0, 0), a2, voffA);
            PG8_WAIT_V(8); PG8_WAIT_L(0); PG8_BAR; PG8_MMA(1, 0, At, B0); PG8_MMA(1, 1, At, B1); PG8_BAR; PG8_SCHED;
            PG8_LDB(B0, 1, 0); PG8_LDB(B1, 1, 1); PG8_SCHED; PG8_LDA(At, 1, 0); PG8_STAGE(PG8_SA(0, 1), a2 + hstepA, voffA);
            PG8_WAIT_V(8); PG8_WAIT_L(0); PG8_BAR; PG8_MMA(0, 0, At, B0); PG8_MMA(0, 1, At, B1); PG8_BAR; PG8_SCHED;
            PG8_LDA(At, 1, 1); PG8_STAGE(PG8_SB(1, 0), b3, voffB); PG8_STAGE(PG8_SB(1, 1), b3 + hstepB, voffB); PG8_STAGE(PG8_SA(1, 0), a3, voffA);
            PG8_WAIT_V(8); PG8_WAIT_L(0); PG8_BAR; PG8_MMA(1, 0, At, B0); PG8_MMA(1, 1, At, B1); PG8_BAR; PG8_SCHED;
        }
        if (wr == 0) PG8_BAR;
        { int fr_e = fr, fq_e = fq; asm volatile("" : "+v"(fr_e), "+v"(fq_e));
          E(acc, cur, wr, wc, fr_e, fq_e); }
        S.done(cur);
        if (!has_next) break;
#pragma unroll
        for (int a = 0; a < 2; ++a)
#pragma unroll
            for (int b = 0; b < 2; ++b)
#pragma unroll
                for (int m = 0; m < 4; ++m)
#pragma unroll
                    for (int n = 0; n < 2; ++n) acc[a][b][m][n] = (f32x4){0.f, 0.f, 0.f, 0.f};
        cur = nxt; cA = nA; cB = nB; ++ui;
        if (wr == 1) PG8_BAR;
    }
    PG8_WAIT_V(0);
    PG8_BAR;
#undef PG8_SA
#undef PG8_SB
#undef PG8_STAGE
#undef PG8_LDA
#undef PG8_LDB
#undef PG8_MMA
}

DEVI void store8(bf16_t* p, const f32x4 a, const f32x4 b) {
    u32x4 w; w.x = cvt_pk_bf16(a[0], a[1]); w.y = cvt_pk_bf16(a[2], a[3]); w.z = cvt_pk_bf16(b[0], b[1]); w.w = cvt_pk_bf16(b[2], b[3]); *(u32x4*)p = w;
}
DEVI float row_rstd(const float* stats, int row) {
    const f32x4* sp = (const f32x4*)(stats + (size_t)row * 16);
    const f32x4 a = sp[0], b = sp[1], c = sp[2], d = sp[3];
    const float s = ((a[0] + a[1]) + (a[2] + a[3])) + ((b[0] + b[1]) + (b[2] + b[3])) + ((c[0] + c[1]) + (c[2] + c[3])) + ((d[0] + d[1]) + (d[2] + d[3]));
    return rsqrtf(s * (1.f / DM) + EPS);
}

DEVI void unit_rstd(const float* stats, int pm, LAS float* rsl, int wr, int wc, int fr, int fq, int tag) {
    volatile LAS int* tagw = (volatile LAS int*)(rsl + 256);
    if (__builtin_amdgcn_readfirstlane(tagw[0]) == tag) return;
    const int t = (wr * 4 + wc) * 64 + fq * 16 + fr, row = t >> 1, hf = t & 1;
    const f32x4* sp = (const f32x4*)(stats + (size_t)(pm * 256 + row) * 16 + hf * 8);
    const f32x4 a = sp[0], b = sp[1];
    float s = ((a[0] + a[1]) + (a[2] + a[3])) + ((b[0] + b[1]) + (b[2] + b[3]));
    s += __shfl_xor(s, 1);
    if (hf == 0) rsl[row] = rsqrtf(s * (1.f / DM) + EPS);
    asm volatile("s_waitcnt lgkmcnt(0)" ::: "memory"); __builtin_amdgcn_s_barrier(); asm volatile("" ::: "memory");
    if (t == 0) tagw[0] = tag;
}
struct EpiIn {
    bf16_t* U; const float* stats; const float* bias; const float* qn_g; const float* kn_g; const float* csh; const float* csr;
    bf16_t* KT; bf16_t* VT; const float* ret_logit; LAS float* xch; LAS float* rsl;
    __device__ __forceinline__ void operator()(f32x4 (&acc)[2][2][4][2], const Unit& u, int wr, int wc, int fr, int fq) const {
        const int pm = u.pm, pn = u.pn;
        const bool lat = pm < 64;
        const int rmod = lat ? (pm >> 3) : 8, bb = lat ? (pm >> 3) : (pm - 64);
        const int pos0 = (pm & 7) * 256, tau0 = lat ? 256 + pos0 : 0;
        const int rowt0 = wr * 64 + fr, w8 = wc * 32 + 8 * fq;
        const bool perm = (pn <= 4) || (pn >= 6 && pn <= 10);
        int cb[2];
#pragma unroll
        for (int bj = 0; bj < 2; ++bj) cb[bj] = perm ? ((w8 >> 6) * 128 + bj * 64 + (w8 & 63)) : (bj * 128 + w8);
        unit_rstd(stats, pm, rsl, wr, wc, fr, fq, (int)(unsigned)(uintptr_t)bias + pm);
        {
            const float* bp = bias + (size_t)rmod * NIN + pn * 256;
            f32x4 bv[2][2];
#pragma unroll
            for (int bj = 0; bj < 2; ++bj)
#pragma unroll
                for (int n = 0; n < 2; ++n) bv[bj][n] = *(const f32x4*)(bp + cb[bj] + 4 * n);
#pragma unroll
            for (int ai = 0; ai < 2; ++ai)
#pragma unroll
                for (int m = 0; m < 4; ++m) {
                    const float rs = rsl[ai * 128 + rowt0 + 16 * m];
#pragma unroll
                    for (int bj = 0; bj < 2; ++bj)
#pragma unroll
                        for (int n = 0; n < 2; ++n) acc[ai][bj][m][n] = acc[ai][bj][m][n] * rs + bv[bj][n];
                }
        }
        bf16_t* Ub = U + (size_t)(pm * 256) * LDU + pn * 256;
        const bool norm = perm && (pn <= 4);
        const bool rope128 = perm, rope256 = (pn >= 12 && pn <= 19), rope = (rope128 || rope256) && lat;
        f32x4 g1[2], g2[2];
        if (norm) {
#pragma unroll
            for (int ai = 0; ai < 2; ++ai)
#pragma unroll
                for (int m = 0; m < 4; ++m) {
                    float s = 0.f;
#pragma unroll
                    for (int bj = 0; bj < 2; ++bj)
#pragma unroll
                        for (int n = 0; n < 2; ++n) { const f32x4 x = acc[ai][bj][m][n]; s += (x[0] * x[0] + x[1] * x[1]) + (x[2] * x[2] + x[3] * x[3]); }
                    s += __shfl_xor(s, 16); s += __shfl_xor(s, 32);
                    if (fq == 0) xch[(ai * 128 + rowt0 + 16 * m) * 4 + wc] = s;
                }
            asm volatile("s_waitcnt lgkmcnt(0)" ::: "memory"); __builtin_amdgcn_s_barrier(); asm volatile("" ::: "memory");
            const float* g = (pn < 4) ? qn_g : kn_g;
            const int dd0 = w8 & 63;
#pragma unroll
            for (int n = 0; n < 2; ++n) { g1[n] = *(const f32x4*)(g + dd0 + 4 * n); g2[n] = *(const f32x4*)(g + 64 + dd0 + 4 * n); }
        }
        const float* tab = rope128 ? csh : csr; const int tw = rope128 ? 64 : 128; const int i0 = rope128 ? (w8 & 63) : w8;
        const int kind = (pn >= 16 && pn <= 19) ? 1 : (pn >= 20 && pn <= 27) ? 2 : (pn >= 36) ? 4 : (pn >= 28) ? 3 : 0;
        float lgf = 0.f, lgb = 0.f; bf16_t* t0p = nullptr; bf16_t* t1p = nullptr;
        if (kind == 1) { const int h = pn - 16; lgf = log2_sigmoid(ret_logit[h]); lgb = log2_sigmoid(ret_logit[4 + h]);
            t0p = KT + ((size_t)((0 * NB + bb) * 4 + h) * 256) * TAU + wc * 4096 + fq * 64; t1p = KT + ((size_t)((1 * NB + bb) * 4 + h) * 256) * TAU + wc * 4096 + fq * 64; }
        if (kind == 2) { const int h = (pn - 20) >> 1, e0 = ((pn - 20) & 1) * 256; t0p = VT + ((size_t)(bb * 4 + h) * 512 + e0 + w8) * TAU + tau0; }
        f32x4 tcur[4], tnxt[4];
        if (rope) { const float* tp = tab + ((size_t)(pos0 + rowt0) * tw + i0) * 2;
#pragma unroll
            for (int j = 0; j < 4; ++j) tcur[j] = *(const f32x4*)(tp + 4 * j); }
#pragma unroll
        for (int ai = 0; ai < 2; ++ai)
#pragma unroll
            for (int m = 0; m < 4; ++m) {
                const int rt = ai * 128 + rowt0 + 16 * m;
                if (rope && (ai * 4 + m) < 7) { const int rtn = ((ai * 4 + m + 1) >> 2) * 128 + rowt0 + 16 * ((ai * 4 + m + 1) & 3); const float* tp = tab + ((size_t)(pos0 + rtn) * tw + i0) * 2;
#pragma unroll
                    for (int j = 0; j < 4; ++j) tnxt[j] = *(const f32x4*)(tp + 4 * j); }
                f32x4 v[2][2];
#pragma unroll
                for (int bj = 0; bj < 2; ++bj)
#pragma unroll
                    for (int n = 0; n < 2; ++n) v[bj][n] = acc[ai][bj][m][n];
                if (norm) {
                    const float tot = xch[rt * 4 + wc] + xch[rt * 4 + (wc ^ 1)];
                    const float hr = rsqrtf(tot * (1.f / 128.f) + EPS);
#pragma unroll
                    for (int n = 0; n < 2; ++n) { v[0][n] = v[0][n] * hr * g1[n]; v[1][n] = v[1][n] * hr * g2[n]; }
                }
                if (rope) {
#pragma unroll
                    for (int n = 0; n < 2; ++n) {
                        const f32x4 ta = tcur[2 * n], tb = tcur[2 * n + 1];
                        const f32x4 x1 = v[0][n], x2 = v[1][n];
                        v[0][n][0] = x1[0] * ta[0] - x2[0] * ta[1]; v[1][n][0] = x1[0] * ta[1] + x2[0] * ta[0];
                        v[0][n][1] = x1[1] * ta[2] - x2[1] * ta[3]; v[1][n][1] = x1[1] * ta[3] + x2[1] * ta[2];
                        v[0][n][2] = x1[2] * tb[0] - x2[2] * tb[1]; v[1][n][2] = x1[2] * tb[1] + x2[2] * tb[0];
                        v[0][n][3] = x1[3] * tb[2] - x2[3] * tb[3]; v[1][n][3] = x1[3] * tb[3] + x2[3] * tb[2];
                    }
                }
                if (kind == 1) {
                    const int sidx = (tau0 + rt) & 127;
                    const size_t okt = (size_t)((tau0 + rt) >> 7) * 32768 + (sidx >> 4) * 512 + ((sidx >> 3) & 1) * 256 + (sidx & 7);
                    const float df = fexp2((float)(127 - sidx) * lgf), db = fexp2((float)sidx * lgb);
#pragma unroll
                    for (int bj = 0; bj < 2; ++bj)
#pragma unroll
                        for (int n = 0; n < 2; ++n) {
                            v[bj][n] = v[bj][n] * 0.0625f;
#pragma unroll
                            for (int i = 0; i < 4; ++i) { const size_t o = okt + bj * 16384 + (4 * n + i) * 8; t0p[o] = f2bf(v[bj][n][i] * df); t1p[o] = f2bf(v[bj][n][i] * db); }
                        }
                } else if (kind == 2) {
#pragma unroll
                    for (int bj = 0; bj < 2; ++bj)
#pragma unroll
                        for (int n = 0; n < 2; ++n)
#pragma unroll
                            for (int i = 0; i < 4; ++i) t0p[(size_t)(bj * 128 + 4 * n + i) * TAU + rt] = f2bf(v[bj][n][i]);
                } else if (kind >= 3) {
#pragma unroll
                    for (int bj = 0; bj < 2; ++bj)
#pragma unroll
                        for (int n = 0; n < 2; ++n)
#pragma unroll
                            for (int i = 0; i < 4; ++i) { const float sg = sigmoidf_(v[bj][n][i]); v[bj][n][i] = (kind == 3) ? v[bj][n][i] * sg : sg; }
                }
                if (kind != 2) {
                    const bool fo = (kind == 1) || (pn >= 12 && pn <= 15);
                    const int r0s = fo ? (rt & ~31) + (cb[0] >> 3) : rt, c0s = fo ? (rt & 31) * 8 : cb[0];
                    const int r1s = fo ? r0s + 16 : rt, c1s = fo ? c0s : cb[1];
                    store8(Ub + (size_t)r0s * LDU + c0s, v[0][0], v[0][1]);
                    store8(Ub + (size_t)r1s * LDU + c1s, v[1][0], v[1][1]);
                }
                if (rope) {
#pragma unroll
                    for (int j = 0; j < 4; ++j) tcur[j] = tnxt[j]; }
                asm volatile("" ::: "memory");
            }
    }
};

struct EpiRes {
    const float* Xin; float* Xout; const float* gate; const float* ng; const float* sc; bf16_t* Ap; float* stats;
    __device__ __forceinline__ void operator()(f32x4 (&acc)[2][2][4][2], const Unit& u, int wr, int wc, int fr, int fq) const {
        const int pm = u.pm, pn = u.pn;
        const int rmod = pm < 64 ? (pm >> 3) : 8;
        const int rowt0 = wr * 64 + fr, w8 = wc * 32 + 8 * fq;
        f32x4 gt[2][2], gm[2][2];
#pragma unroll
        for (int bj = 0; bj < 2; ++bj)
#pragma unroll
            for (int n = 0; n < 2; ++n) {
                const int col = pn * 256 + bj * 128 + w8 + 4 * n;
                gt[bj][n] = *(const f32x4*)(gate + (size_t)rmod * NMOD + col);
                if (ng) { const f32x4 a = *(const f32x4*)(ng + col), b = *(const f32x4*)(sc + (size_t)rmod * NMOD + col); gm[bj][n] = a * (b + 1.0f); }
                else gm[bj][n] = (f32x4){0.f, 0.f, 0.f, 0.f};
            }
        f32x4 xc[4], xn[4];
        {   const size_t off = ((size_t)pm * 256 + rowt0) * DM + pn * 256 + w8;
            xc[0] = *(const f32x4*)(Xin + off); xc[1] = *(const f32x4*)(Xin + off + 4); xc[2] = *(const f32x4*)(Xin + off + 128); xc[3] = *(const f32x4*)(Xin + off + 132); }
#pragma unroll
        for (int ai = 0; ai < 2; ++ai)
#pragma unroll
            for (int m = 0; m < 4; ++m) {
                const size_t row = (size_t)pm * 256 + ai * 128 + rowt0 + 16 * m;
                if (ai * 4 + m < 7) {
                    const size_t rown = (size_t)pm * 256 + ((ai * 4 + m + 1) >> 2) * 128 + rowt0 + 16 * ((ai * 4 + m + 1) & 3);
                    const size_t off = rown * DM + pn * 256 + w8;
                    xn[0] = *(const f32x4*)(Xin + off); xn[1] = *(const f32x4*)(Xin + off + 4); xn[2] = *(const f32x4*)(Xin + off + 128); xn[3] = *(const f32x4*)(Xin + off + 132); }
                float ss = 0.f;
#pragma unroll
                for (int bj = 0; bj < 2; ++bj) {
                    const size_t off = row * DM + pn * 256 + bj * 128 + w8;
                    f32x4 x0 = xc[2 * bj], x1 = xc[2 * bj + 1];
                    x0 = x0 + gt[bj][0] * acc[ai][bj][m][0]; x1 = x1 + gt[bj][1] * acc[ai][bj][m][1];
                    *(f32x4*)(Xout + off) = x0; *(f32x4*)(Xout + off + 4) = x1;
                    ss += ((x0[0] * x0[0] + x0[1] * x0[1]) + (x0[2] * x0[2] + x0[3] * x0[3])) + ((x1[0] * x1[0] + x1[1] * x1[1]) + (x1[2] * x1[2] + x1[3] * x1[3]));
                    if (ng) store8(Ap + off, x0 * gm[bj][0], x1 * gm[bj][1]);
                }
                ss += __shfl_xor(ss, 16); ss += __shfl_xor(ss, 32);
                if (fq == 0) stats[row * 16 + pn * 4 + wc] = ss;
#pragma unroll
                for (int j = 0; j < 4; ++j) xc[j] = xn[j];
                asm volatile("" ::: "memory");
            }
    }
};

struct EpiFfn1 {
    bf16_t* H; const float* stats; const float* bias; LAS float* rsl;
    __device__ __forceinline__ void operator()(f32x4 (&acc)[2][2][4][2], const Unit& u, int wr, int wc, int fr, int fq) const {
        const int pm = u.pm, pn = u.pn;
        const int rmod = pm < 64 ? (pm >> 3) : 8;
        const int rowt0 = wr * 64 + fr, w8 = wc * 32 + 8 * fq;
        unit_rstd(stats, pm, rsl, wr, wc, fr, fq, (int)(unsigned)(uintptr_t)bias + pm);
        f32x4 bv[2][2];
#pragma unroll
        for (int bj = 0; bj < 2; ++bj)
#pragma unroll
            for (int n = 0; n < 2; ++n) bv[bj][n] = *(const f32x4*)(bias + (size_t)rmod * DFF + pn * 256 + bj * 128 + w8 + 4 * n);
#pragma unroll
        for (int ai = 0; ai < 2; ++ai)
#pragma unroll
            for (int m = 0; m < 4; ++m) {
                const size_t row = (size_t)pm * 256 + ai * 128 + rowt0 + 16 * m;
                const float rs = rsl[ai * 128 + rowt0 + 16 * m];
#pragma unroll
                for (int bj = 0; bj < 2; ++bj) {
                    f32x4 v0 = acc[ai][bj][m][0] * rs + bv[bj][0], v1 = acc[ai][bj][m][1] * rs + bv[bj][1];
#pragma unroll
                    for (int i = 0; i < 4; ++i) { v0[i] = fmaxf(v0[i], 0.f); v0[i] *= v0[i]; v1[i] = fmaxf(v1[i], 0.f); v1[i] *= v1[i]; }
                    store8(H + row * LDU + pn * 256 + bj * 128 + w8, v0, v1);
                }
            }
    }
};

template <int ACCUM> struct EpiMerge1 {
    bf16_t* U; int goff;
    __device__ __forceinline__ void operator()(f32x4 (&acc)[2][2][4][2], const Unit& u, int wr, int wc, int fr, int fq) const {
        const int pm = u.pm, pn = u.pn;
        const int rowt0 = wr * 64 + fr, w8 = wc * 32 + 8 * fq;
#pragma unroll
        for (int ai = 0; ai < 2; ++ai)
#pragma unroll
            for (int m = 0; m < 4; ++m) {
                const size_t row = (size_t)pm * 256 + ai * 128 + rowt0 + 16 * m;
#pragma unroll
                for (int bj = 0; bj < 2; ++bj) {
                    const int col = pn * 256 + bj * 128 + w8;
                    const u32x4 gw = *(const u32x4*)(U + row * LDU + goff + col);
                    f32x4 v0, v1;
                    v0[0] = bf_lo(gw.x) * acc[ai][bj][m][0][0]; v0[1] = bf_hi(gw.x) * acc[ai][bj][m][0][1]; v0[2] = bf_lo(gw.y) * acc[ai][bj][m][0][2]; v0[3] = bf_hi(gw.y) * acc[ai][bj][m][0][3];
                    v1[0] = bf_lo(gw.z) * acc[ai][bj][m][1][0]; v1[1] = bf_hi(gw.z) * acc[ai][bj][m][1][1]; v1[2] = bf_lo(gw.w) * acc[ai][bj][m][1][2]; v1[3] = bf_hi(gw.w) * acc[ai][bj][m][1][3];
                    bf16_t* yp = U + row * LDU + YOFF + col;
                    if (ACCUM) { const u32x4 pw = *(const u32x4*)yp;
                        v0[0] += bf_lo(pw.x); v0[1] += bf_hi(pw.x); v0[2] += bf_lo(pw.y); v0[3] += bf_hi(pw.y); v1[0] += bf_lo(pw.z); v1[1] += bf_hi(pw.z); v1[2] += bf_lo(pw.w); v1[3] += bf_hi(pw.w); }
                    store8(yp, v0, v1);
                }
            }
    }
};
}

namespace att {
constexpr int D = 128, NW = 8, QBLK = 32, KVBLK = 64;
constexpr float SCALE = 0.088388347648318440f;
constexpr float THR = 8.f;
constexpr size_t SHM_V = KVBLK * D * 2, SHM_K = KVBLK * D * 2, SHM_ATTN = 2 * SHM_V + 2 * SHM_K + NW * 64 * 4;
#define KSWZ(row, colB) ((row) * 256 + ((colB) ^ (((row) & 7) << 4)))
#define SBAR() __builtin_amdgcn_sched_barrier(0)
struct AUnit { const bf16_t* Q; bf16_t* O; const bf16_t* K; const bf16_t* V; int base1, n1, base2, NT; int mask, q0pos, k0pos; float m0, l0; };
DEVI void partialSM(f32x16& p0, f32x16& p1, float& m_reg, float& mn, float& alpha) {
    constexpr float C = SCALE * 1.4426950408889634f;
    float pmax = p0[0];
#pragma unroll
    for (int r = 1; r < 16; ++r) pmax = fmaxf(pmax, p0[r]);
#pragma unroll
    for (int r = 0; r < 16; ++r) pmax = fmaxf(pmax, p1[r]);
    { auto rr = __builtin_amdgcn_permlane32_swap(__float_as_uint(pmax), __float_as_uint(pmax), false, false);
      pmax = fmaxf(__uint_as_float(rr[0]), __uint_as_float(rr[1])); }
    if (__builtin_expect(__all(pmax - m_reg <= THR / SCALE), 1)) { mn = m_reg; alpha = 1.f; }
    else { mn = fmaxf(m_reg, pmax); alpha = __builtin_amdgcn_exp2f((m_reg - mn) * C); m_reg = mn; }
    const float mnC = -mn * C;
#pragma unroll
    for (int r = 0; r < 16; ++r) p0[r] = fmaf(p0[r], C, mnC);
#pragma unroll
    for (int r = 0; r < 16; ++r) p1[r] = fmaf(p1[r], C, mnC);
#pragma unroll
    for (int r = 0; r < 16; ++r) p0[r] = __builtin_amdgcn_exp2f(p0[r]);
}
DEVI void finishSM(f32x16& p0, f32x16& p1, float alpha, float& l_reg, bf16x8& pa0, bf16x8& pa1, bf16x8& pa2, bf16x8& pa3) {
#pragma unroll
    for (int r = 0; r < 16; ++r) p1[r] = __builtin_amdgcn_exp2f(p1[r]);
    float ps = 0;
#pragma unroll
    for (int r = 0; r < 16; ++r) ps += p0[r];
#pragma unroll
    for (int r = 0; r < 16; ++r) ps += p1[r];
    { auto rr = __builtin_amdgcn_permlane32_swap(__float_as_uint(ps), __float_as_uint(ps), false, false);
      ps = __uint_as_float(rr[0]) + __uint_as_float(rr[1]); }
    l_reg = l_reg * alpha + ps;
#define PK4(P, BASE, OUT) do { unsigned a0 = cvt_pk_bf16(P[BASE + 0], P[BASE + 1]), a1 = cvt_pk_bf16(P[BASE + 2], P[BASE + 3]);   \
    unsigned b0 = cvt_pk_bf16(P[BASE + 4], P[BASE + 5]), b1 = cvt_pk_bf16(P[BASE + 6], P[BASE + 7]);                              \
    auto r0 = __builtin_amdgcn_permlane32_swap(a0, b0, false, false); auto r1 = __builtin_amdgcn_permlane32_swap(a1, b1, false, false); \
    u32x4 w = {r0[0], r1[0], r0[1], r1[1]}; OUT = __builtin_bit_cast(bf16x8, w); } while (0)
    PK4(p0, 0, pa0); PK4(p0, 8, pa1); PK4(p1, 0, pa2); PK4(p1, 8, pa3);
#undef PK4
}
DEVI void qkt(f32x16& p0, f32x16& p1, const char* Ks, const bf16x8* qr, int r32, int hi) {
    p0 = f32x16{}; p1 = f32x16{};
#pragma unroll
    for (int d0 = 0; d0 < 8; ++d0) { const int cb = (d0 * 16 + hi * 8) * 2;
        const bf16x8 b0 = *reinterpret_cast<const bf16x8*>(Ks + KSWZ(r32, cb));
        const bf16x8 b1 = *reinterpret_cast<const bf16x8*>(Ks + KSWZ(32 + r32, cb));
        p0 = MFMA32(b0, qr[d0], p0);
        p1 = MFMA32(b1, qr[d0], p1); }
}
DEVI int v_st(int k, int c) { const int kk = (k & ~0xC) | ((k & 4) << 1) | ((k & 8) >> 1); return ((kk >> 3) * 4 + (c >> 5)) * 512 + ((kk & 7) * 32 + (c & 31)) * 2; }
DEVI int v_rd_base(int lane) { return ((lane & 3) << 3) | (((lane >> 2) & 3) << 6) | (((lane >> 4) & 1) << 5) | (((lane >> 5) & 1) << 8); }
constexpr int v_rd_off(int d0, int ks, int half) { return d0 * 512 + ks * 4096 + half * 2048; }
template <int OFF> DEVI s16x4 tr_read(int vb) { s16x4 r; asm volatile("ds_read_b64_tr_b16 %0, %1 offset:%2" : "=&v"(r) : "v"(vb), "i"(OFF) : "memory"); return r; }
template <int D0> DEVI void pv_one(f32x16& od, int vb, bf16x8 pa0, bf16x8 pa1, bf16x8 pa2, bf16x8 pa3) {
    const s16x4 l0 = tr_read<v_rd_off(D0, 0, 0)>(vb), h0 = tr_read<v_rd_off(D0, 0, 1)>(vb), l1 = tr_read<v_rd_off(D0, 1, 0)>(vb), h1 = tr_read<v_rd_off(D0, 1, 1)>(vb);
    const s16x4 l2 = tr_read<v_rd_off(D0, 2, 0)>(vb), h2 = tr_read<v_rd_off(D0, 2, 1)>(vb), l3 = tr_read<v_rd_off(D0, 3, 0)>(vb), h3 = tr_read<v_rd_off(D0, 3, 1)>(vb);
    asm volatile("s_waitcnt lgkmcnt(0)" ::: "memory"); SBAR();
#define PK(L, H) (bf16x8){L[0], L[1], L[2], L[3], H[0], H[1], H[2], H[3]}
    od = MFMA32(pa0, PK(l0, h0), od);
    od = MFMA32(pa1, PK(l1, h1), od);
    od = MFMA32(pa2, PK(l2, h2), od);
    od = MFMA32(pa3, PK(l3, h3), od);
#undef PK
}
DEVI void pv_d0(f32x16* o, int vb, bf16x8 pa0, bf16x8 pa1, bf16x8 pa2, bf16x8 pa3) {
    pv_one<0>(o[0], vb, pa0, pa1, pa2, pa3); pv_one<1>(o[1], vb, pa0, pa1, pa2, pa3); pv_one<2>(o[2], vb, pa0, pa1, pa2, pa3); pv_one<3>(o[3], vb, pa0, pa1, pa2, pa3);
}
DEVI void band_mask(f32x16& p0, f32x16& p1, int qpos, int kt0, int hi) {
#pragma unroll
    for (int r = 0; r < 16; ++r) {
        const int k0 = kt0 + crow(r, hi), d0 = qpos - k0, d1 = d0 - 32;
        if (d0 > 128 || d0 < -128) p0[r] = -INFINITY;
        if (d1 > 128 || d1 < -128) p1[r] = -INFINITY;
    }
}
DEVI void attn_unit(const AUnit& u, char* lds) {
    const int tid = fresh_tid();
    const int wid = tid >> 6, lane = tid & 63, r32 = lane & 31, hi = lane >> 5;
    char* V_lds = lds; char* K_lds = lds + 2 * SHM_V;
    float* ws = (float*)(lds + 2 * SHM_V + 2 * SHM_K) + wid * 64; float* li_l = ws; float* al_l = ws + 32;
    float m_reg = u.m0, l_reg = u.l0; f32x16 o[4] = {}; bf16x8 qr[8];
    const bf16_t* Qw = u.Q + (size_t)(wid * QBLK + r32) * LDU + hi * 8;
#pragma unroll
    for (int d0 = 0; d0 < 8; ++d0) qr[d0] = *reinterpret_cast<const bf16x8*>(Qw + d0 * 16);
    const int sr = tid >> 4, sc = (tid & 15) * 8, vst0 = v_st(sr, sc), vst1 = v_st(32 + sr, sc);
    const int vb0 = (int)(uintptr_t)V_lds + v_rd_base(lane);
    const int qpos = u.q0pos + wid * QBLK + r32;
    struct { bf16x8 vs0, vs1, ks0, ks1; } sr_[2];
#define TROW(t) ((t) < u.n1 ? u.base1 + 64 * (t) : u.base2 + 64 * ((t) - u.n1))
#define SLOAD(i, t) do { const size_t r0_ = (size_t)(TROW(t) + sr) * LDU + sc; \
    sr_[i].vs0 = *reinterpret_cast<const bf16x8*>(u.V + r0_); sr_[i].vs1 = *reinterpret_cast<const bf16x8*>(u.V + r0_ + (size_t)32 * LDU); \
    sr_[i].ks0 = *reinterpret_cast<const bf16x8*>(u.K + r0_); sr_[i].ks1 = *reinterpret_cast<const bf16x8*>(u.K + r0_ + (size_t)32 * LDU); } while (0)
#define SWRITE(b, i) do { *(bf16x8*)(V_lds + (b) * SHM_V + vst0) = sr_[i].vs0;          \
    *(bf16x8*)(V_lds + (b) * SHM_V + vst1) = sr_[i].vs1; const int kc = sc * 2;               \
    *(bf16x8*)(K_lds + (b) * SHM_K + KSWZ(sr, kc)) = sr_[i].ks0;                       \
    *(bf16x8*)(K_lds + (b) * SHM_K + KSWZ(32 + sr, kc)) = sr_[i].ks1; } while (0)
#define SWAIT() asm volatile("s_waitcnt vmcnt(4)" ::: "memory")
#define RESC(a) do { if (__any((a) < 1.f)) { if (hi == 0) al_l[r32] = (a); asm volatile("s_waitcnt lgkmcnt(0)" ::: "memory"); \
    _Pragma("unroll") for (int d = 0; d < 4; ++d) _Pragma("unroll") for (int r = 0; r < 16; ++r) o[d][r] *= al_l[crow(r, hi)]; } } while (0)
#define MASK(P0, P1, t) do { if (u.mask && (t) < u.n1) band_mask(P0, P1, qpos, u.k0pos + 64 * (t), hi); } while (0)
    f32x16 pA0, pA1, pB0, pB1; float mnA, mnB, alA, alB; bf16x8 pa0, pa1, pa2, pa3; const int NT = u.NT;
    constexpr int SE = 0, SO = 1;
    SLOAD(SE, 0); asm volatile("s_waitcnt vmcnt(0)" ::: "memory"); SWRITE(0, SE); __syncthreads();
    qkt(pA0, pA1, K_lds, qr, r32, hi); MASK(pA0, pA1, 0); partialSM(pA0, pA1, m_reg, mnA, alA);
    SLOAD(SO, 1); if (2 < NT) SLOAD(SE, 2);
    if (2 < NT) SWAIT(); else asm volatile("s_waitcnt vmcnt(0)" ::: "memory");
    SWRITE(1, SO); __syncthreads();
    RESC(alA);
    for (int j = 1; j + 1 < NT; j += 2) {
        SBAR(); qkt(pB0, pB1, K_lds + SHM_K, qr, r32, hi); MASK(pB0, pB1, j);
        finishSM(pA0, pA1, alA, l_reg, pa0, pa1, pa2, pa3); SBAR();
        if (j + 2 < NT) SLOAD(SO, j + 2); SBAR();
        pv_d0(o, vb0, pa0, pa1, pa2, pa3); partialSM(pB0, pB1, m_reg, mnB, alB);
        __syncthreads(); if (j + 2 < NT) SWAIT(); else asm volatile("s_waitcnt vmcnt(0)" ::: "memory"); SWRITE(0, SE);
        RESC(alB); __syncthreads();
        SBAR(); qkt(pA0, pA1, K_lds, qr, r32, hi); MASK(pA0, pA1, j + 1);
        finishSM(pB0, pB1, alB, l_reg, pa0, pa1, pa2, pa3); SBAR();
        if (j + 3 < NT) SLOAD(SE, j + 3); SBAR();
        pv_d0(o, vb0 + (int)SHM_V, pa0, pa1, pa2, pa3); partialSM(pA0, pA1, m_reg, mnA, alA);
        __syncthreads(); if (j + 3 < NT) SWAIT(); else asm volatile("s_waitcnt vmcnt(0)" ::: "memory"); SWRITE(1, SO);
        RESC(alA); __syncthreads();
    }
    SBAR(); qkt(pB0, pB1, K_lds + SHM_K, qr, r32, hi); MASK(pB0, pB1, NT - 1);
    finishSM(pA0, pA1, alA, l_reg, pa0, pa1, pa2, pa3); SBAR();
    pv_d0(o, vb0, pa0, pa1, pa2, pa3); partialSM(pB0, pB1, m_reg, mnB, alB);
    __syncthreads(); RESC(alB);
    finishSM(pB0, pB1, alB, l_reg, pa0, pa1, pa2, pa3); SBAR();
    pv_d0(o, vb0 + (int)SHM_V, pa0, pa1, pa2, pa3);
    if (hi == 0) li_l[r32] = l_reg; asm volatile("s_waitcnt lgkmcnt(0)" ::: "memory");
    float rli[16];
#pragma unroll
    for (int r = 0; r < 16; ++r) rli[r] = __builtin_amdgcn_rcpf(li_l[crow(r, hi)]);
    bf16_t* Ow = u.O + (size_t)(wid * QBLK) * LDU;
#pragma unroll
    for (int r = 0; r < 16; ++r) { const int orow = crow(r, hi);
#pragma unroll
        for (int d0 = 0; d0 < 4; ++d0) Ow[(size_t)orow * LDU + d0 * 32 + r32] = f2bf(o[d0][r] * rli[r]); }
    __syncthreads();
#undef TROW
#undef SLOAD
#undef SWRITE
#undef SWAIT
#undef RESC
#undef MASK
}
}

namespace ret {
constexpr int ST_P = 264, VT_P = 136, ATT_P = 136;
constexpr int LDS_ST = 0, LDS_VT = 64 * ST_P * 2, VT_SZ = 64 * VT_P * 2, LDS_Q = LDS_VT + 2 * VT_SZ, LDS_SCAN_BYTES = LDS_Q + 128 * ST_P * 2;
constexpr int LDS_ATT = 0, LDS_XL = 128 * ATT_P * 2, LDS_VS = LDS_XL + 128 * 2 * 4, LDS_INTRA_BYTES = LDS_VS + 256 * ATT_P * 2;
DEVI bf16x8 ld8(const bf16_t* p) { return *reinterpret_cast<const bf16x8*>(p); }
#define RET_GEO(step_, dir_, row_, tau_) do { if ((step_) < 2) { const int j_ = (dir_) ? 1 - (step_) : (step_); row_ = M_LAT + b * CTX + 128 * j_; tau_ = 128 * j_; } \
        else { const int c_ = (dir_) ? 17 - (step_) : (step_) - 2; row_ = b * SEQ + 128 * c_; tau_ = 256 + 128 * c_; } } while (0)
DEVI void scan_unit(int b, int h, int es, bf16_t* U, const bf16_t* KT, const bf16_t* VT, float lgf, float lgb, char* lds, unsigned* done_cnt) {
    const int tid = fresh_tid();
    const int w = __builtin_amdgcn_readfirstlane(tid >> 6), lane = tid & 63;
    bf16_t* st_l = (bf16_t*)(lds + LDS_ST); bf16_t* ql = (bf16_t*)(lds + LDS_Q);
    const bf16_t* VTe = VT + ((size_t)(b * 4 + h) * 512 + es * 64) * TAU;
    const int rb = w >> 1, cb = w & 1;
    const int ve = tid >> 3, vp = (tid & 7) * 16;
    const int ocvB = ((((es >> 1) & 1) * 8) + 4 * (es >> 2) + 2 * (es & 1) + cb) * 2;
    for (int dir = 0; dir < 2; ++dir) {
        const float lg = dir ? lgb : lgf;
        const float cdec = fexp2(128.f * lg);
        const bf16_t* KTd = KT + ((size_t)((dir * NB + b) * 4 + h) * 256) * TAU;
        f32x16 accS[2]; accS[0] = f32x16{}; accS[1] = f32x16{};
        bf16x8 kfA[8], kfB[8], qs[8], vs0, vs1; u32x2 oldA[4], oldB[4];
        {
            int row0, tau0; RET_GEO(0, dir, row0, tau0); (void)row0;
            const int r32 = lane & 31, hi = lane >> 5;
            const bf16_t* kp = KTd + (size_t)(tau0 >> 7) * 32768 + w * 4096 + lane * 8;
#pragma unroll
            for (int k0 = 0; k0 < 8; ++k0) kfA[k0] = ld8(kp + 512 * k0);
            vs0 = ld8(VTe + (size_t)ve * TAU + tau0 + vp); vs1 = ld8(VTe + (size_t)ve * TAU + tau0 + vp + 8);
            bf16_t* vl = (bf16_t*)(lds + LDS_VT) + ve * VT_P + vp;
            *(bf16x8*)vl = vs0; *(bf16x8*)(vl + 8) = vs1;
            __syncthreads();
        }
#define SCAN_STEP(step, KC, KN, OC, ON) do { \
            float lgs = lg; int lane_s = lane; asm volatile("" : "+v"(lgs), "+v"(lane_s)); \
            const int r32 = lane_s & 31, hi = lane_s >> 5; \
            int row0, tau0, row1 = 0, tau1 = 0; RET_GEO(step, dir, row0, tau0); (void)tau0; \
            const bool more = (step) < 17; \
            if (more) RET_GEO((step) + 1, dir, row1, tau1); \
            const bf16_t* vl_cur = (const bf16_t*)(lds + LDS_VT + ((step) & 1) * VT_SZ); \
            bf16_t* vl_nxt = (bf16_t*)(lds + LDS_VT + (((step) + 1) & 1) * VT_SZ); \
            if (more) {     \
                vs0 = ld8(VTe + (size_t)ve * TAU + tau1 + vp); vs1 = ld8(VTe + (size_t)ve * TAU + tau1 + vp + 8); \
                const bf16_t* qg = U + (size_t)row1 * LDU + CQ + h * 256; \
                _Pragma("unroll") for (int j = 0; j < 8; ++j) { const int idx = tid + 512 * j; qs[j] = ld8(qg + (size_t)(idx >> 5) * LDU + 8 * (idx & 31)); } \
                const bf16_t* kp = KTd + (size_t)(tau1 >> 7) * 32768 + w * 4096 + lane_s * 8; \
                _Pragma("unroll") for (int k0 = 0; k0 < 8; ++k0) KN[k0] = ld8(kp + 512 * k0); \
                if (dir) { const bf16_t* op1 = U + (size_t)(row1 + 32 * rb + ocvB) * LDU + CV + h * 512 + lane_s * 4; \
                    _Pragma("unroll") for (int g = 0; g < 4; ++g) ON[g] = *(const u32x2*)(op1 + (size_t)(g >> 1) * LDU + (g & 1) * 256); } \
            } \
            bf16_t* op = U + (size_t)(row0 + 32 * rb + ocvB) * LDU + CV + h * 512 + lane_s * 4; \
            f32x16 acc = f32x16{}; \
            if ((step) > 0) {     \
                const bf16_t* sp = st_l + (32 * cb + r32) * ST_P + 8 * hi; \
                const bf16_t* qp = ql + (32 * rb + hi) * ST_P + 8 * r32; \
                f32x16 acc2 = f32x16{};     \
                _Pragma("unroll") for (int k0 = 0; k0 < 16; k0 += 2) { const bf16x8 a = ld8(sp + 16 * k0), a2 = ld8(sp + 16 * k0 + 16); const bf16x8 bq = ld8(qp + 2 * k0 * ST_P), bq2 = ld8(qp + (2 * k0 + 2) * ST_P); \
                    acc = MFMA32(a, bq, acc); acc2 = MFMA32(a2, bq2, acc2); } \
                _Pragma("unroll") for (int r = 0; r < 16; ++r) acc[r] += acc2[r]; \
                const int qi = 32 * rb + r32; \
                const float sc = fexp2((float)(dir ? 128 - qi : qi + 1) * lgs); \
                _Pragma("unroll") for (int r = 0; r < 16; ++r) acc[r] *= sc; \
            } \
            if (!dir || (step) > 0) { \
                _Pragma("unroll") for (int g = 0; g < 4; ++g) { \
                    float v0 = acc[4 * g], v1 = acc[4 * g + 1], v2 = acc[4 * g + 2], v3 = acc[4 * g + 3]; \
                    if (dir) { v0 += bf_lo(OC[g].x); v1 += bf_hi(OC[g].x); v2 += bf_lo(OC[g].y); v3 += bf_hi(OC[g].y); } \
                    u32x2 pk; pk.x = cvt_pk_bf16(v0, v1); pk.y = cvt_pk_bf16(v2, v3); *(u32x2*)(op + (size_t)(g >> 1) * LDU + (g & 1) * 256) = pk; } \
            } \
            if (more) {     \
                _Pragma("unroll") for (int r = 0; r < 16; ++r) { accS[0][r] *= cdec; accS[1][r] *= cdec; } \
                const bf16_t* vp0 = vl_cur + r32 * VT_P + 8 * hi; \
                _Pragma("unroll") for (int k0 = 0; k0 < 8; ++k0) { const bf16x8 b0 = ld8(vp0 + 16 * k0), b1 = ld8(vp0 + 32 * VT_P + 16 * k0); \
                    accS[0] = MFMA32(KC[k0], b0, accS[0]); accS[1] = MFMA32(KC[k0], b1, accS[1]); } \
            } \
            __syncthreads(); \
            if (more) { \
                _Pragma("unroll") for (int c2 = 0; c2 < 2; ++c2) _Pragma("unroll") for (int g = 0; g < 4; ++g) { \
                    u32x2 pk; pk.x = cvt_pk_bf16_c(accS[c2][4 * g], accS[c2][4 * g + 1]); pk.y = cvt_pk_bf16_c(accS[c2][4 * g + 2], accS[c2][4 * g + 3]); \
                    *(u32x2*)(st_l + (32 * c2 + r32) * ST_P + 32 * w + 8 * g + 4 * hi) = pk; } \
                bf16_t* vl = vl_nxt + ve * VT_P + vp; \
                *(bf16x8*)vl = vs0; *(bf16x8*)(vl + 8) = vs1; \
                _Pragma("unroll") for (int j = 0; j < 8; ++j) { const int idx = tid + 512 * j; *(bf16x8*)(ql + (idx >> 5) * ST_P + 8 * (idx & 31)) = qs[j]; } \
            } \
            __syncthreads(); \
        } while (0)
        for (int pr = 0; pr < 9; ++pr) {
            SCAN_STEP(2 * pr, kfA, kfB, oldA, oldB);
            SCAN_STEP(2 * pr + 1, kfB, kfA, oldB, oldA);
        }
#undef SCAN_STEP
    }
    asm volatile("s_waitcnt vmcnt(0)" ::: "memory"); __syncthreads();
    if (tid < 64) { __builtin_amdgcn_fence(__ATOMIC_RELEASE, "agent"); asm volatile("s_waitcnt vmcnt(0)" ::: "memory");
        if (tid == 0) __hip_atomic_fetch_add(done_cnt, 1u, __ATOMIC_RELAXED, __HIP_MEMORY_SCOPE_AGENT); }
}
DEVI void intra_unit(int b, int h, int ci, bf16_t* U, const bf16_t* VT, const float* gn, float lgf, float lgb, char* lds) {
    const int tid = fresh_tid();
    const int w = __builtin_amdgcn_readfirstlane(tid >> 6), lane = tid & 63, r32 = lane & 31, hi = lane >> 5;
    bf16_t* att_l = (bf16_t*)(lds + LDS_ATT); float* xl = (float*)(lds + LDS_XL);
    int row0, tau0;
    if (ci < 2) { row0 = M_LAT + b * CTX + 128 * ci; tau0 = 128 * ci; } else { row0 = b * SEQ + 128 * (ci - 2); tau0 = 256 + 128 * (ci - 2); }
    const int rb = w >> 1;
    bf16x8 stg0[8];
    {   const bf16_t* vbase0 = VT + ((size_t)(b * 4 + h) * 512) * TAU + tau0;
#pragma unroll
        for (int j = 0; j < 8; ++j) { const int idx = tid + 512 * j, row = idx >> 4, pc = idx & 15; stg0[j] = ld8(vbase0 + (size_t)row * TAU + 8 * pc); } }
    {
        const bf16_t* Qc = U + (size_t)row0 * LDU + CQ + h * 256;
        const bf16_t* Kc = U + (size_t)row0 * LDU + CK + h * 256;
        const int cb0 = 2 * (w & 1);
        f32x16 a0 = f32x16{}, a1 = f32x16{};
        const bf16_t* qp = Qc + (size_t)(32 * rb + hi) * LDU + r32 * 8;
        const bf16_t* kp0 = Kc + (size_t)(cb0 * 32 + hi) * LDU + r32 * 8; const bf16_t* kp1 = kp0 + (size_t)32 * LDU;
#pragma unroll 8
        for (int k0 = 0; k0 < 16; ++k0) {
            const bf16x8 a = ld8(qp + (size_t)(2 * k0) * LDU); const bf16x8 b0 = ld8(kp0 + (size_t)(2 * k0) * LDU), b1 = ld8(kp1 + (size_t)(2 * k0) * LDU);
            a0 = MFMA32(a, b0, a0); a1 = MFMA32(a, b1, a1);
        }
#pragma unroll
        for (int r = 0; r < 16; ++r) {
            const int qi = 32 * rb + crow(r, hi);
            const int s0 = 32 * cb0 + r32, s1 = s0 + 32;
            const int d0 = qi - s0, d1 = qi - s1;
            const float f0 = d0 > 0 ? fexp2((float)d0 * lgf) : (d0 < 0 ? fexp2((float)(-d0) * lgb) : 2.f);
            const float f1 = d1 > 0 ? fexp2((float)d1 * lgf) : (d1 < 0 ? fexp2((float)(-d1) * lgb) : 2.f);
            att_l[qi * ATT_P + s0] = f2bf(a0[r] * f0); att_l[qi * ATT_P + s1] = f2bf(a1[r] * f1);
        }
    }
    __syncthreads();
    const int sub = w & 1;
    f32x16 acc[8];
    {
        bf16x8 bfr[8];
        const bf16_t* ap = att_l + (32 * rb + r32) * ATT_P + 8 * hi;
#pragma unroll
        for (int k0 = 0; k0 < 8; ++k0) bfr[k0] = ld8(ap + 16 * k0);
        bf16_t* vt_l = (bf16_t*)(lds + LDS_VS);
        const bf16_t* vbase = VT + ((size_t)(b * 4 + h) * 512) * TAU + tau0;
#pragma unroll
        for (int p = 0; p < 2; ++p) {
            bf16x8 stg[8];
#pragma unroll
            for (int j = 0; j < 8; ++j) { const int idx = tid + 512 * j, row = idx >> 4, pc = idx & 15; stg[j] = p ? ld8(vbase + (size_t)(256 + row) * TAU + 8 * pc) : stg0[j]; }
            if (p) __syncthreads();
#pragma unroll
            for (int j = 0; j < 8; ++j) { const int idx = tid + 512 * j, row = idx >> 4, pc = idx & 15; *(bf16x8*)(vt_l + row * ATT_P + 8 * pc) = stg[j]; }
            __syncthreads();
            const bf16_t* vp = vt_l + (128 * sub + r32) * ATT_P + 8 * hi;
#pragma unroll
            for (int t = 0; t < 4; ++t) {
                f32x16 c = f32x16{};
#pragma unroll
                for (int k0 = 0; k0 < 8; ++k0) { const bf16x8 a = ld8(vp + (32 * t) * ATT_P + 16 * k0); c = MFMA32(a, bfr[k0], c); }
                acc[4 * p + t] = c;
            }
        }
    }
    bf16_t* orow = U + (size_t)(row0 + 32 * rb + r32) * LDU + h * 512 + 128 * sub + 4 * hi;
#define EOFF(t) (256 * ((t) >> 2) + 32 * ((t) & 3))
    float ss = 0.f;
#pragma unroll
    for (int t = 0; t < 8; ++t)
#pragma unroll
        for (int g = 0; g < 4; ++g) {
            const u32x2 ow = *(const u32x2*)(U + (size_t)(row0 + 32 * rb + (sub * 8 + t) * 2 + (g >> 1)) * LDU + CV + h * 512 + (g & 1) * 256 + lane * 4);
            acc[t][4 * g] += bf_lo(ow.x); acc[t][4 * g + 1] += bf_hi(ow.x); acc[t][4 * g + 2] += bf_lo(ow.y); acc[t][4 * g + 3] += bf_hi(ow.y);
#pragma unroll
            for (int i = 0; i < 4; ++i) ss += acc[t][4 * g + i] * acc[t][4 * g + i];
        }
    ss += __shfl_xor(ss, 32);
    if (hi == 0) xl[(32 * rb + r32) * 2 + sub] = ss;
    __syncthreads();
    const float rs = rsqrtf((xl[(32 * rb + r32) * 2] + xl[(32 * rb + r32) * 2 + 1]) * (1.f / 512.f) + EPS);
    const float* gnp = gn + h * 512 + 128 * sub + 4 * hi;
#pragma unroll
    for (int t = 0; t < 8; ++t)
#pragma unroll
        for (int g = 0; g < 4; ++g) {
            bf16_t* gp = orow + CG + EOFF(t) + 8 * g;
            const u32x2 gw = *(const u32x2*)gp; const f32x4 nn = *(const f32x4*)(gnp + EOFF(t) + 8 * g);
            u32x2 pk;
            pk.x = cvt_pk_bf16(acc[t][4 * g] * rs * nn[0] * bf_lo(gw.x), acc[t][4 * g + 1] * rs * nn[1] * bf_hi(gw.x));
            pk.y = cvt_pk_bf16(acc[t][4 * g + 2] * rs * nn[2] * bf_lo(gw.y), acc[t][4 * g + 3] * rs * nn[3] * bf_hi(gw.y));
            *(u32x2*)gp = pk;
        }
#undef EOFF
    __syncthreads();
}
}

#define XB_TMO      128
#define XB_XCNT(j)  (256  + 64 * (j))
#define XB_XSUB(j)  (1280 + 64 * (j))
#define XB_XGEN(j)  (2304 + 64 * (j))
#define XB_TOP      3328
#define XB_TOPGEN   3392
#define XCD_BAR_WORDS 3456
#define XB_SPIN_CAP (1u << 21)
DEVI unsigned xb_ld(unsigned* p)              { return __hip_atomic_load(p, __ATOMIC_RELAXED, __HIP_MEMORY_SCOPE_AGENT); }
DEVI unsigned xb_add(unsigned* p, unsigned v) { return __hip_atomic_fetch_add(p, v, __ATOMIC_RELAXED, __HIP_MEMORY_SCOPE_AGENT); }
DEVI unsigned xb_xcc_id() { return (unsigned)__builtin_amdgcn_s_getreg((3 << 11) | 20) & 0xFu; }
#define XB_SPIN(cond, bar) do { unsigned _sp = 0; while (cond) { __builtin_amdgcn_s_sleep(1); \
    if ((++_sp & 255u) == 0u) { if (xb_ld(&(bar)[XB_TMO])) break; if (_sp > XB_SPIN_CAP) { atomicAdd(&(bar)[XB_TMO], 1u); break; } } } } while (0)
struct XcdBarrier { unsigned* bar; unsigned x; volatile LAS unsigned* st; };
DEVI XcdBarrier xcd_barrier_post(unsigned* bar, volatile LAS unsigned* st) {
    XcdBarrier b; b.bar = bar; b.x = xb_xcc_id(); b.st = st;
    if (threadIdx.x == 0) (void)xb_add(&bar[XB_XCNT(b.x)], 1u);
    return b;
}
DEVI void xcd_barrier_complete(unsigned* bar, unsigned x, unsigned& nloc, unsigned& nx) {
    const unsigned G = gridDim.x * gridDim.y * gridDim.z;
    unsigned sum, cnt, mine, sp = 0u;
    for (;;) {
        sum = 0u; cnt = 0u; mine = 0u;
#pragma unroll
        for (unsigned j = 0; j < 16; ++j) { const unsigned c = xb_ld(&bar[XB_XCNT(j)]); sum += c; cnt += (c > 0u) ? 1u : 0u; mine = (j == x) ? c : mine; }
        if (sum == G) break;
        __builtin_amdgcn_s_sleep(1);
        if ((++sp & 255u) == 0u) { if (xb_ld(&bar[XB_TMO])) break; if (sp > XB_SPIN_CAP) { atomicAdd(&bar[XB_TMO], 1u); break; } }
    }
    nloc = mine > 0u ? mine : 1u; nx = cnt > 0u ? cnt : 1u;
}
DEVI void xcd_barrier(unsigned* bar_, volatile LAS unsigned* st_) {
    asm volatile("s_waitcnt vmcnt(0)" ::: "memory");
    __syncthreads();
    if (threadIdx.x == 0) {
        XcdBarrier b; b.bar = bar_; b.x = xb_xcc_id(); b.st = st_;
        unsigned* bar = b.bar;
        __builtin_amdgcn_s_waitcnt(0);
        unsigned nloc = b.st[0], nx = b.st[1];
        if (nloc == 0u) { xcd_barrier_complete(bar, b.x, nloc, nx); b.st[0] = nloc; b.st[1] = nx; }
        const unsigned old = xb_add(&bar[XB_XSUB(b.x)], 1u);
        const unsigned gen = old / nloc;
        if (old + 1u == (gen + 1u) * nloc) {
            __builtin_amdgcn_fence(__ATOMIC_RELEASE, "agent");
            asm volatile("s_waitcnt vmcnt(0)" ::: "memory");
            const unsigned og = xb_add(&bar[XB_TOP], 1u);
            const unsigned tg = og / nx;
            if (og + 1u == (tg + 1u) * nx) xb_add(&bar[XB_TOPGEN], 1u);
            else XB_SPIN(xb_ld(&bar[XB_TOPGEN]) == tg, bar);
            __builtin_amdgcn_fence(__ATOMIC_ACQUIRE, "agent");
            xb_add(&bar[XB_XGEN(b.x)], 1u);
            asm volatile("s_waitcnt vmcnt(0)" ::: "memory");
        } else {
            XB_SPIN(xb_ld(&bar[XB_XGEN(b.x)]) == gen, bar);
            __builtin_amdgcn_fence(__ATOMIC_ACQUIRE, "agent");
            asm volatile("s_waitcnt vmcnt(0)" ::: "memory");
        }
    }
    __syncthreads();
}

constexpr int NTHR = 512;
constexpr int LDS_XCH = 131072, LDS_MISC = 139264, LDS_RSL = LDS_MISC + 256, LDS_TOTAL = LDS_RSL + 1024 + 16;
static_assert(ret::LDS_SCAN_BYTES <= LDS_MISC, "scan LDS vs control words");
struct Params { const float* in[21]; float* out; unsigned char* ws; int ph_lo, ph_hi; };
enum { I_X = 0, I_C, I_CTX, I_CCTX, I_WADA, I_BADA, I_N1G, I_N2G, I_WIN, I_QNG, I_KNG, I_SINK, I_RLOGIT, I_RNG, I_WPA, I_WPB, I_WPC, I_WO, I_WF1, I_WF2, I_FG };

DEVI int perm_row(int n) {
    const bool p = (n < 1280) || (n >= 1536 && n < 2816);
    if (!p) return n;
    const int t = n & 255, hd = t >> 7, bj = (t >> 6) & 1, dd = t & 63;
    return (n & ~255) + 128 * bj + 64 * hd + dd;
}
DEVI void transpose_item(const float* W, int K, int N, bf16_t* WT, bool perm, LAS float* scr, int item, int lane) {
    const int nblk = N / 32, kb = item / nblk, nb = item % nblk, k0 = 64 * kb, n0 = 32 * nb;
    {
        f32x4 v[8];
        const float* wp = W + (size_t)(k0 + (lane >> 3)) * N + n0 + 4 * (lane & 7);
#pragma unroll
        for (int i = 0; i < 8; ++i) v[i] = *(const f32x4*)(wp + (size_t)(8 * i) * N);
#pragma unroll
        for (int i = 0; i < 8; ++i) { LAS float* d = scr + (8 * i + (lane >> 3)) * 33 + 4 * (lane & 7); d[0] = v[i][0]; d[1] = v[i][1]; d[2] = v[i][2]; d[3] = v[i][3]; }
    }
    asm volatile("s_waitcnt lgkmcnt(0)" ::: "memory");
    const int c = lane & 7;
#pragma unroll
    for (int j = 0; j < 4; ++j) { const int n = (lane >> 3) + 8 * j; const LAS float* s = scr + (8 * c) * 33 + n;
        u32x4 o; o.x = cvt_pk_bf16(s[0 * 33], s[1 * 33]); o.y = cvt_pk_bf16(s[2 * 33], s[3 * 33]); o.z = cvt_pk_bf16(s[4 * 33], s[5 * 33]); o.w = cvt_pk_bf16(s[6 * 33], s[7 * 33]);
        const int nd = perm ? perm_row(n0 + n) : (n0 + n);
        *(u32x4*)(WT + (size_t)nd * K + k0 + 8 * c) = o; }
    asm volatile("s_waitcnt lgkmcnt(0)" ::: "memory");
}
DEVI void convert_weight(const float* W, int K, int N, bf16_t* WT, bool perm, LAS unsigned char* lds, int bid, int nb) {
    const int tid = fresh_tid(); const int wave = tid >> 6, lane = tid & 63;
    LAS float* scr = (LAS float*)(lds + wave * 16384);
    const int items = (K / 64) * (N / 32);
    for (int it = bid * 8 + wave; it < items; it += nb * 8) transpose_item(W, K, N, WT, perm, scr, it, lane);
}
DEVI void dot9_item(const float* W, int ldw, int n0, const float* bvec, float* out, int ldo, LAS float* sL, LAS float* red) {
    const int tid = fresh_tid(); const int wave = tid >> 6, lane = tid & 63;
    float a[9];
#pragma unroll
    for (int r = 0; r < 9; ++r) a[r] = 0.f;
    const float* wp = W + (size_t)(wave * 128) * ldw + n0 + lane;
#pragma unroll 8
    for (int k = 0; k < 128; ++k) { const float wv = wp[(size_t)k * ldw];
#pragma unroll
        for (int r = 0; r < 9; ++r) a[r] += sL[r * 1024 + wave * 128 + k] * wv; }
#pragma unroll
    for (int r = 0; r < 9; ++r) red[(wave * 9 + r) * 64 + lane] = a[r];
    __syncthreads();
    for (int o = tid; o < 9 * 64; o += NTHR) { const int r = o >> 6, c = o & 63; float s = 0.f;
#pragma unroll
        for (int w = 0; w < 8; ++w) s += red[(w * 9 + r) * 64 + c];
        out[(size_t)r * ldo + n0 + c] = s + (bvec ? bvec[n0 + c] : 0.f); }
    __syncthreads();
}
DEVI void sincos_f(float ang, float& c, float& s) {
    const float q = rintf(ang * 0.6366197723675814f);
    float r = fmaf(-q, 1.5703125f, ang); r = fmaf(-q, 4.837512969970703125e-4f, r); r = fmaf(-q, 7.549789948768648e-8f, r);
    const float r2 = r * r;
    const float sp = r + r * r2 * (-1.6666667163e-1f + r2 * (8.3333337680e-3f + r2 * (-1.9841270114e-4f + r2 * 2.7557314297e-6f)));
    const float cp = 1.f + r2 * (-0.5f + r2 * (4.1666667908e-2f + r2 * (-1.3888889225e-3f + r2 * (2.4801587642e-5f + r2 * -2.7557314297e-7f))));
    const int qi = ((int)q) & 3;
    c = (qi == 0) ? cp : (qi == 1) ? -sp : (qi == 2) ? -cp : sp;
    s = (qi == 0) ? sp : (qi == 1) ? cp : (qi == 2) ? -sp : -cp;
}

__global__ void __launch_bounds__(NTHR, 2) mega_fwd(Params P) {
    extern __shared__ __attribute__((aligned(16))) unsigned char lds_raw[];
    cg::grid_group grid = cg::this_grid();
    LAS unsigned char* lds = (LAS unsigned char*)lds_raw;
    const int G = gridDim.x, NGW = G * 8;
#define PHASE_IDS() const int tid = fresh_tid(); const int wave = tid >> 6, lane = tid & 63, gw = blockIdx.x * 8 + wave; (void)lane; (void)gw; (void)wave
    unsigned char* ws = P.ws;
    bf16_t* U = (bf16_t*)(ws + WS_U); float* X = (float*)(ws + WS_X); bf16_t* AP = (bf16_t*)(ws + WS_AP);
    bf16_t* KT = (bf16_t*)(ws + WS_KT); bf16_t* VT = (bf16_t*)(ws + WS_VT);
    bf16_t* Wb = (bf16_t*)(ws + WS_W);
    bf16_t* Win_t = (bf16_t*)(ws + WS_W + W_IN);
    float* MOD = (float*)(ws + WS_MOD); float* B1 = (float*)(ws + WS_B1); float* B2 = (float*)(ws + WS_B2); float* ST = (float*)(ws + WS_ST);
    float* CSH = (float*)(ws + WS_CSH); float* CSR = (float*)(ws + WS_CSR); unsigned* CTR = (unsigned*)(ws + WS_CTR);
    (void)Wb;
    int ph = 0;
    {   volatile LAS unsigned* st0 = (volatile LAS unsigned*)(lds + LDS_MISC + 64); if (threadIdx.x < 2) st0[threadIdx.x] = 0u; if (threadIdx.x == 2) ((volatile LAS int*)(lds + LDS_RSL + 1024))[0] = (int)0xFFFFFFFEu; }
    __syncthreads();
    (void)xcd_barrier_post((unsigned*)(ws + WS_BAR), (volatile LAS unsigned*)(lds + LDS_MISC + 64));
#define GRID_SYNC_CG() do { asm volatile("s_waitcnt vmcnt(0) lgkmcnt(0)" ::: "memory"); grid.sync(); \
        if (threadIdx.x < 64) { __builtin_amdgcn_fence(__ATOMIC_ACQUIRE, "agent"); asm volatile("s_waitcnt vmcnt(0)" ::: "memory"); } __syncthreads(); } while (0)
#define GRID_SYNC_X() xcd_barrier((unsigned*)(P.ws + WS_BAR), (volatile LAS unsigned*)(lds + LDS_MISC + 64))
    if (P.ph_hi < 0) GRID_SYNC_CG();
#define GRID_SYNC(ty) GRID_SYNC_X()
#define PHASE_ON() (P.ph_lo <= ph && ph < P.ph_hi)
#ifdef PROBE_MASK
    unsigned long long t_prev = __builtin_amdgcn_s_memrealtime(), t_sel = 0ull;
#define PHASE_END(ty) do { if (P.ph_lo <= ph && ph + 1 < P.ph_hi) GRID_SYNC(ty); ++ph; \
        { const unsigned long long t_now = __builtin_amdgcn_s_memrealtime(); if ((PROBE_MASK >> (ty)) & 1) t_sel += t_now - t_prev; t_prev = t_now; } } while (0)
#else
#define PHASE_END(ty) do { if (P.ph_lo <= ph && ph + 1 < P.ph_hi) GRID_SYNC(ty); ++ph; } while (0)
#endif

    if (PHASE_ON()) { PHASE_IDS();
        if (blockIdx.x == 0 && tid < 128) CTR[tid] = 0u;
        if (blockIdx.x == 0 && tid < 5 * 72) ((unsigned*)(ws + WS_CNT))[tid * 64] = 0u;
#ifdef DIAG_FILL
        { u32x4* p = (u32x4*)(ws + WS_U); const size_t n16 = (WS_W - WS_U) / 16; const u32x4 z = {0u, 0u, 0u, 0u};
          for (size_t i = (size_t)blockIdx.x * NTHR + tid; i < n16; i += (size_t)G * NTHR) { if (i * 16 >= WS_X && i * 16 < WS_AP) continue; p[i] = z; } }
#endif
        {
            LAS float* sL = (LAS float*)lds; LAS float* red = (LAS float*)(lds + 9 * 1024 * 4);
            for (int i = tid; i < 9 * 1024; i += NTHR) { const float v = (i < 8192) ? P.in[I_C][i] : P.in[I_CCTX][i - 8192]; sL[i] = v * sigmoidf_(v); }
            __syncthreads();
            for (int it = blockIdx.x; it < DEPTH * (NMOD / 64); it += G) { const int l = it / (NMOD / 64), n0 = (it % (NMOD / 64)) * 64;
                dot9_item(P.in[I_WADA] + (size_t)l * DM * NMOD, NMOD, n0, P.in[I_BADA] + (size_t)l * NMOD, MOD + (size_t)l * 9 * NMOD, NMOD, sL, red); }
            __syncthreads();
        }
        bf16_t* Wpa_t = (bf16_t*)(ws + WS_W + W_PA); bf16_t* Wpb_t = (bf16_t*)(ws + WS_W + W_PB); bf16_t* Wpc_t = (bf16_t*)(ws + WS_W + W_PC);
        bf16_t* Wo_t = (bf16_t*)(ws + WS_W + W_O); bf16_t* Wf1_t = (bf16_t*)(ws + WS_W + W_F1); bf16_t* Wf2_t = (bf16_t*)(ws + WS_W + W_F2);
        convert_weight(P.in[I_WIN], DM, NIN, Win_t, true, lds, (int)blockIdx.x, G);
        convert_weight(P.in[I_WPA], DM, DM, Wpa_t, false, lds, (int)blockIdx.x, G);
        convert_weight(P.in[I_WPB], DM, DM, Wpb_t, false, lds, (int)blockIdx.x, G);
        convert_weight(P.in[I_WPC], 2048, DM, Wpc_t, false, lds, (int)blockIdx.x, G);
        convert_weight(P.in[I_WO], DM, DM, Wo_t, false, lds, (int)blockIdx.x, G);
        convert_weight(P.in[I_WF1], DM, DFF, Wf1_t, false, lds, (int)blockIdx.x, G);
        convert_weight(P.in[I_WF2], DFF, DM, Wf2_t, false, lds, (int)blockIdx.x, G);
        for (int i = blockIdx.x * NTHR + tid; i < SEQ * 64; i += G * NTHR) { const int pos = i >> 6, dd = i & 63, j = dd & 31, p = dd < 32 ? (pos >> 6) : (pos & 63);
            const float inv = fexp2(-(float)j * (13.287712379549449f / 32.f)); float c, s; sincos_f((float)p * inv, c, s); CSH[2 * i] = c; CSH[2 * i + 1] = s; }
        for (int i = blockIdx.x * NTHR + tid; i < SEQ * 128; i += G * NTHR) { const int pos = i >> 7, dd = i & 127, j = dd & 63, p = dd < 64 ? (pos >> 6) : (pos & 63);
            const float inv = fexp2(-(float)j * (13.287712379549449f / 64.f)); float c, s; sincos_f((float)p * inv, c, s); CSR[2 * i] = c; CSR[2 * i + 1] = s; }
        __syncthreads();
    }
    PHASE_END(0);

    if (PHASE_ON()) { PHASE_IDS();
        LAS float* sL = (LAS float*)lds; LAS float* red = (LAS float*)(lds + 9 * 1024 * 4);
        constexpr int IT1 = NIN / 64, IT2 = DFF / 64;
        for (int it = blockIdx.x; it < DEPTH * (IT1 + IT2); it += G) {
            const int l = it / (IT1 + IT2), r = it % (IT1 + IT2); const bool first = r < IT1;
            const float* md = MOD + (size_t)l * 9 * NMOD + (first ? 0 : 3 * DM);
            for (int i = tid; i < 9 * 1024; i += NTHR) sL[i] = md[(size_t)(i >> 10) * NMOD + (i & 1023)];
            __syncthreads();
            if (first) dot9_item(P.in[I_WIN] + (size_t)l * DM * NIN, NIN, r * 64, nullptr, B1 + (size_t)l * 9 * NIN, NIN, sL, red);
            else dot9_item(P.in[I_WF1] + (size_t)l * DM * DFF, DFF, (r - IT1) * 64, nullptr, B2 + (size_t)l * 9 * DFF, DFF, sL, red);
        }
        for (int row = gw; row < M_ALL; row += NGW) {
            const bool lat = row < M_LAT; const int rmod = lat ? (row >> 11) : 8;
            const float* src = lat ? P.in[I_X] + (size_t)row * DM : P.in[I_CTX] + (size_t)(row - M_LAT) * DM;
            const float* scp = MOD + (size_t)rmod * NMOD + DM; const float* ng = P.in[I_N1G];
            float ss = 0.f;
#pragma unroll
            for (int j = 0; j < 4; ++j) { const int c = 4 * lane + 256 * j; const f32x4 v = *(const f32x4*)(src + c);
                *(f32x4*)(X + (size_t)row * DM + c) = v; ss += (v[0] * v[0] + v[1] * v[1]) + (v[2] * v[2] + v[3] * v[3]);
                const f32x4 g = *(const f32x4*)(ng + c), s = *(const f32x4*)(scp + c); const f32x4 a = v * (g * (s + 1.0f));
                u32x2 pk; pk.x = cvt_pk_bf16(a[0], a[1]); pk.y = cvt_pk_bf16(a[2], a[3]); *(u32x2*)(AP + (size_t)row * DM + c) = pk; }
            ss = wave_sum(ss);
            if (lane < 16) ST[(size_t)row * 16 + lane] = lane == 0 ? ss : 0.f;
        }
    }
    PHASE_END(1);

    for (int l = 0; l < DEPTH; ++l) {
        const bool need_ctx = l < DEPTH - 1;
        const float* MODl = MOD + (size_t)l * 9 * NMOD;
        const int M2 = need_ctx ? M_ALL : M_LAT;
        const size_t wsm = (l & 1) ? W_SM : 0;
        bf16_t* Wpa_t = (bf16_t*)(ws + WS_W + W_PA + wsm); bf16_t* Wpb_t = (bf16_t*)(ws + WS_W + W_PB + wsm); bf16_t* Wpc_t = (bf16_t*)(ws + WS_W + W_PC + wsm);
        bf16_t* Wo_t = (bf16_t*)(ws + WS_W + W_O + wsm); bf16_t* Wf1_t = (bf16_t*)(ws + WS_W + W_F1 + wsm); bf16_t* Wf2_t = (bf16_t*)(ws + WS_W + W_F2 + wsm);
        if (PHASE_ON()) { PHASE_IDS();
            pg8::Gemm g{AP, DM, Win_t, DM}; pg8::StaticOrder S; S.init(M_ALL, NIN, G, (int)blockIdx.x);
            if (l > 0) { S.ready = (const unsigned*)(ws + WS_CNT) + 3 * 72 * 64; S.need = 4u * (unsigned)l; }
            if (l == DEPTH - 1) { S.init(M_LAT, NIN, G, (int)blockIdx.x); S.ready = (const unsigned*)(ws + WS_CNT) + 3 * 72 * 64; S.need = 4u * (unsigned)l; S.nextra = 128; }
            pg8::EpiIn E{U, ST, B1 + (size_t)l * 9 * NIN, P.in[I_QNG] + l * 128, P.in[I_KNG] + l * 128, CSH, CSR, KT, VT, P.in[I_RLOGIT] + l * 8, (LAS float*)(lds + LDS_XCH), (LAS float*)(lds + LDS_RSL)};
            pg8::gemm_phase(lds, g, S, E);
        }
        PHASE_END(2);
        if (PHASE_ON()) { PHASE_IDS();
#ifdef PROBE_MASK
            const unsigned long long tc0 = __builtin_amdgcn_s_memrealtime();
#endif
#ifdef PROBE_MASK
            if ((PROBE_MASK >> 10) & 1) t_sel += __builtin_amdgcn_s_memrealtime() - tc0;
#endif
            LAS int* misc = (LAS int*)(lds + LDS_MISC);
            const int nq = (G % 8 == 0) ? 8 : 1, qx = (int)blockIdx.x % nq, qslot = (int)blockIdx.x / nq, qn = G / nq;
            for (int sl = qslot; sl < 256 / nq; sl += qn) {
                const int pair = nq == 8 ? 4 * qx + (sl >> 3) : (sl >> 3), es = sl & 7, b = pair >> 2, h = pair & 3;
                const float lgf = log2_sigmoid(P.in[I_RLOGIT][l * 8 + h]), lgb = log2_sigmoid(P.in[I_RLOGIT][l * 8 + 4 + h]);
                ret::scan_unit(b, h, es, U, KT, VT, lgf, lgb, (char*)lds_raw, (unsigned*)(ws + WS_CNT) + (4 * 72 + b * 4 + h) * 64);
            }
            const int per_b = 128 + (need_ctx ? 16 : 0), nb_q = NB / nq, qtotal = per_b * nb_q;
            for (;;) {
                if (tid == 0) misc[0] = (int)atomicAdd(&CTR[l * 16 + qx], 1u);
                __syncthreads();
                const int ui = misc[0];
                __syncthreads();
                if (ui >= qtotal) break;
                {
                    att::AUnit a; const int b = (nq == 8) ? qx : ui / per_b; int i = ui % per_b;
                    if (i < 64) {
                        const int h = i >> 3, qb = i & 7, kv = h >> 2; const size_t qrow = (size_t)b * SEQ + qb * 256;
                        a.Q = U + qrow * LDU + AQ + h * 128; a.O = U + qrow * LDU + AQ + h * 128; a.K = U + AK + kv * 128; a.V = U + AV + kv * 128;
                        a.base1 = b * SEQ; a.n1 = 32; a.base2 = M_LAT + b * CTX; a.NT = 36; a.mask = 0; a.q0pos = 0; a.k0pos = 0; a.m0 = -1e30f; a.l0 = 0.f;
                    } else if (i < 128) {
                        i -= 64; const int h = i >> 3, qb = i & 7, kv = h >> 2; const size_t qrow = (size_t)b * SEQ + qb * 256;
                        const int ks = qb == 0 ? 0 : qb * 256 - 128, ke = qb == 7 ? SEQ : qb * 256 + 384;
                        a.Q = U + qrow * LDU + BQ + h * 128; a.O = U + qrow * LDU + BQ + h * 128; a.K = U + BKO + kv * 128; a.V = U + BV + kv * 128;
                        a.base1 = b * SEQ + ks; a.n1 = (ke - ks) / 64; a.base2 = M_LAT + b * CTX; a.NT = a.n1 + 4; a.mask = 1; a.q0pos = qb * 256; a.k0pos = ks;
                        a.m0 = P.in[I_SINK][l * 8 + h] * (1.f / att::SCALE); a.l0 = 1.f;
                    } else {
                        i -= 128; const int isb = i >> 3, h = i & 7, kv = h >> 2; const size_t qrow = (size_t)M_LAT + b * CTX;
                        const int qo = isb ? BQ : AQ, ko = isb ? BKO : AK, vo = isb ? BV : AV;
                        a.Q = U + qrow * LDU + qo + h * 128; a.O = U + qrow * LDU + qo + h * 128; a.K = U + ko + kv * 128; a.V = U + vo + kv * 128;
                        a.base1 = 0; a.n1 = 0; a.base2 = M_LAT + b * CTX; a.NT = 4; a.mask = 0; a.q0pos = 0; a.k0pos = 0;
                        a.m0 = isb ? P.in[I_SINK][l * 8 + h] * (1.f / att::SCALE) : -1e30f; a.l0 = isb ? 1.f : 0.f;
                    }
                    att::attn_unit(a, (char*)lds_raw);
                }
            }
        }
        ++ph;
        if (PHASE_ON()) { PHASE_IDS();
            const float* gn = P.in[I_RNG] + (size_t)l * 2048;
            const int nch = need_ctx ? 18 : 16, total = NB * 4 * nch;
            const int nconv = (l + 1 < DEPTH) ? 400 : 0;
            LAS int* misc = (LAS int*)(lds + LDS_MISC);
            for (;;) {
                if (tid == 0) misc[0] = (int)atomicAdd(&CTR[96 + l], 1u);
                __syncthreads();
                const int u = misc[0];
                __syncthreads();
                if (u >= total + nconv) break;
                if (u < total) {
                    const int bh = u / nch, ci = u % nch + (need_ctx ? 0 : 2), b = bh >> 2, h = bh & 3;
                    const float lgf = log2_sigmoid(P.in[I_RLOGIT][l * 8 + h]), lgb = log2_sigmoid(P.in[I_RLOGIT][l * 8 + 4 + h]);
                    {
                        if (tid < 64) { const unsigned* rc = (const unsigned*)(ws + WS_CNT) + (4 * 72 + b * 4 + h) * 64;
                            while ((unsigned)__builtin_amdgcn_readfirstlane(__hip_atomic_load(rc, __ATOMIC_RELAXED, __HIP_MEMORY_SCOPE_AGENT)) < 8u * (unsigned)(l + 1)) {
                                __builtin_amdgcn_s_sleep(2); }
                            __builtin_amdgcn_fence(__ATOMIC_ACQUIRE, "agent"); asm volatile("s_waitcnt vmcnt(0)" ::: "memory"); }
                        __syncthreads();
                    }
                    ret::intra_unit(b, h, ci, U, VT, gn, lgf, lgb, (char*)lds_raw);
                } else {
                    const size_t wsn = ((l + 1) & 1) ? W_SM : 0;
                    LAS float* scr = (LAS float*)(lds + wave * 16384);
#pragma unroll 1
                    for (int j = 0; j < 4; ++j) {
                        int g = (u - total) * 32 + wave * 4 + j;
                        if (g < 6144) { transpose_item(P.in[I_WIN] + (size_t)(l + 1) * DM * NIN, DM, NIN, Win_t, true, scr, g, lane); continue; } g -= 6144;
                        if (g < 512) { transpose_item(P.in[I_WPA] + (size_t)(l + 1) * DM * DM, DM, DM, (bf16_t*)(ws + WS_W + W_PA + wsn), false, scr, g, lane); continue; } g -= 512;
                        if (g < 512) { transpose_item(P.in[I_WPB] + (size_t)(l + 1) * DM * DM, DM, DM, (bf16_t*)(ws + WS_W + W_PB + wsn), false, scr, g, lane); continue; } g -= 512;
                        if (g < 1024) { transpose_item(P.in[I_WPC] + (size_t)(l + 1) * 2048 * DM, 2048, DM, (bf16_t*)(ws + WS_W + W_PC + wsn), false, scr, g, lane); continue; } g -= 1024;
                        if (g < 512) { transpose_item(P.in[I_WO] + (size_t)(l + 1) * DM * DM, DM, DM, (bf16_t*)(ws + WS_W + W_O + wsn), false, scr, g, lane); continue; } g -= 512;
                        if (g < 2048) { transpose_item(P.in[I_WF1] + (size_t)(l + 1) * DM * DFF, DM, DFF, (bf16_t*)(ws + WS_W + W_F1 + wsn), false, scr, g, lane); continue; } g -= 2048;
                        if (g < 2048) transpose_item(P.in[I_WF2] + (size_t)(l + 1) * DFF * DM, DFF, DM, (bf16_t*)(ws + WS_W + W_F2 + wsn), false, scr, g, lane);
                    }
                }
            }
        }
        PHASE_END(4);
        if (PHASE_ON()) { PHASE_IDS();
            unsigned* cntY = (unsigned*)(ws + WS_CNT); unsigned* cntX = cntY + 72 * 64; unsigned* cntH = cntX + 72 * 64;
            const int c = (int)blockIdx.x;
            const unsigned ep = (unsigned)(l + 1);
            {
                pg8::ChainOrder S; S.init(4, G, c, need_ctx ? 32 : 0, 0, nullptr, 0u, nullptr);
                { pg8::Gemm g{U + AQ, LDU, Wpa_t, DM}; pg8::EpiMerge1<0> E{U, GA}; pg8::gemm_phase(lds, g, S, E); }
                { pg8::Gemm g{U + BQ, LDU, Wpb_t, DM}; pg8::EpiMerge1<1> E{U, GB}; pg8::gemm_phase(lds, g, S, E); }
                S.pub = cntY;
                { pg8::Gemm g{U + CG, LDU, Wpc_t, 2048}; pg8::EpiMerge1<1> E{U, GC}; pg8::gemm_phase(lds, g, S, E); }
            }
            {
                pg8::ChainOrder S; S.init(4, G, c, need_ctx ? 32 : 0, 64, cntY, 4u * ep, cntX);
                pg8::Gemm g{U + YOFF, LDU, Wo_t, DM};
                pg8::EpiRes E{X, X, MODl + 2 * DM, P.in[I_N2G] + (size_t)l * DM, MODl + 4 * DM, AP, ST};
                pg8::gemm_phase(lds, g, S, E);
            }
            {
                pg8::ChainOrder S; S.init(16, G, c, need_ctx ? 128 : 0, 0, cntX, 4u * ep, cntH);
                pg8::Gemm g{AP, DM, Wf1_t, DM};
                pg8::EpiFfn1 E{U, ST, B2 + (size_t)l * 9 * DFF, (LAS float*)(lds + LDS_RSL)};
                pg8::gemm_phase(lds, g, S, E);
            }
            {
                pg8::ChainOrder S; S.init(4, G, c, need_ctx ? 32 : 0, 224, cntH, 16u * ep, need_ctx ? cntH + 72 * 64 : nullptr);
                pg8::Gemm g{U, LDU, Wf2_t, DFF};
                const float* MODn = MOD + (size_t)(l + 1) * 9 * NMOD;
                pg8::EpiRes E{X, need_ctx ? X : P.out, MODl + 5 * DM, need_ctx ? P.in[I_N1G] + (size_t)(l + 1) * DM : nullptr, need_ctx ? MODn + DM : nullptr, AP, ST};
                pg8::gemm_phase(lds, g, S, E);
            }
        }
        if (need_ctx) { ++ph; } else { PHASE_END(5); }
    }
    if (PHASE_ON()) { PHASE_IDS();
        const float* fg = P.in[I_FG];
        for (int row = gw; row < M_LAT; row += NGW) {
            const float rs = pg8::row_rstd(ST, row);
#pragma unroll
            for (int j = 0; j < 4; ++j) { const int c = 4 * lane + 256 * j; float* p = P.out + (size_t)row * DM + c;
                const f32x4 v = *(const f32x4*)p, g = *(const f32x4*)(fg + c); *(f32x4*)p = v * rs * g; }
        }
    }
#ifdef PROBE_MASK
    if (blockIdx.x == 0) { const unsigned long long t0 = __builtin_amdgcn_s_memrealtime(); while (__builtin_amdgcn_s_memrealtime() - t0 < t_sel) __builtin_amdgcn_s_sleep(32); }
#endif
}
constexpr int N_PHASES = 2 + 4 * DEPTH + 1;

extern "C" void kernel_launch(void* const* d_in, const int* in_sizes, int n_in, void* d_out, int out_size, void* d_ws, size_t ws_size, hipStream_t stream) {
    static int grid = 0;
    if (grid == 0) {
        if (n_in != 21 || out_size != M_LAT * DM || ws_size < WS_END) { fprintf(stderr, "kernel_launch: unexpected shapes (n_in %d out %d ws %zu need %zu)\n", n_in, out_size, ws_size, (size_t)WS_END); grid = -1; return; }
        int dev = 0, cus = 0, per_cu = 0;
        hipGetDevice(&dev); hipDeviceGetAttribute(&cus, hipDeviceAttributeMultiprocessorCount, dev);
        if (hipFuncSetAttribute((const void*)mega_fwd, hipFuncAttributeMaxDynamicSharedMemorySize, LDS_TOTAL) != hipSuccess) { fprintf(stderr, "kernel_launch: LDS attribute failed\n"); grid = -1; return; }
        hipOccupancyMaxActiveBlocksPerMultiprocessor(&per_cu, (const void*)mega_fwd, NTHR, LDS_TOTAL);
        if (per_cu < 1) { fprintf(stderr, "kernel_launch: occupancy query says %d\n", per_cu); per_cu = 1; }
        (void)hipGetLastError();
        grid = cus;
    }
    if (grid < 0) return;
    if (hipMemsetAsync((char*)d_ws + WS_BAR, 0, 16384, stream) != hipSuccess) { fprintf(stderr, "kernel_launch: memset of the barrier words failed\n"); return; }
    Params p{};
    for (int i = 0; i < 21; ++i) p.in[i] = (const float*)d_in[i];
    p.out = (float*)d_out; p.ws = (unsigned char*)d_ws; p.ph_lo = 0; p.ph_hi = N_PHASES;
    void* args[] = {&p};
    hipError_t e = hipLaunchCooperativeKernel((const void*)mega_fwd, dim3(grid), dim3(NTHR), args, LDS_TOTAL, stream);
    if (e != hipSuccess) fprintf(stderr, "cooperative launch failed: %s (grid %d)\n", hipGetErrorString(e), grid);
}
```
